# Optimizing an MI355X kernel written in HIP

```python
import functools
import jax, jax.numpy as jnp
from jax import lax
import numpy as np

D_MODEL = 1024
BATCH = 16
SEQ = 256
DEPTH = 2
DEC_BATCH = 8
DEC_SEQ = 4096
PAST_LEN = 512

GRID_W = 64
HEAD_DIM = 64
HQ_ATTN = D_MODEL // (2 * HEAD_DIM)
KV_ATTN = HQ_ATTN // 4
HQ_SWA = D_MODEL // (2 * HEAD_DIM)
KV_SWA = HQ_SWA // 4
WINDOW = 128
Q_BLOCK = 128
ROPE_THETA = 10000.0
RET_DK = 256
RET_DV = 512
RET_HEADS = D_MODEL // RET_DK
RET_CHUNK = 128
D_FF = 4 * D_MODEL
EPS = 1e-6
NEG_INF = -1e30
ADA_CHUNKS = 6

ATTN_Q_W = HQ_ATTN * HEAD_DIM
ATTN_KV_W = KV_ATTN * HEAD_DIM
SWA_Q_W = HQ_SWA * HEAD_DIM
SWA_KV_W = KV_SWA * HEAD_DIM
ATTN_SPLITS = [ATTN_Q_W, ATTN_Q_W + ATTN_KV_W, ATTN_Q_W + 2 * ATTN_KV_W,
               ATTN_Q_W + 2 * ATTN_KV_W + SWA_Q_W, ATTN_Q_W + 2 * ATTN_KV_W + SWA_Q_W + SWA_KV_W]
ATTN_IN_W = ATTN_Q_W + 2 * ATTN_KV_W + SWA_Q_W + 2 * SWA_KV_W
ATTN_OUT_W = ATTN_Q_W + SWA_Q_W
RET_QK_W = RET_HEADS * RET_DK
RET_V_W = RET_HEADS * RET_DV
RET_SPLITS = [RET_QK_W, 2 * RET_QK_W, 2 * RET_QK_W + RET_V_W]
RET_IN_W = 2 * RET_QK_W + 2 * RET_V_W

kernel_name = 'hybrid_diffusion_prefix_step'


def _rms(x, gain):
    x32 = x.astype(jnp.float32)
    y = x32 * lax.rsqrt(jnp.mean(x32 * x32, axis=-1, keepdims=True) + EPS)
    return (y * gain.astype(jnp.float32)).astype(x.dtype)


def _rope_1d(x, ang):
    cos = jnp.cos(ang)[None, :, None, :]
    sin = jnp.sin(ang)[None, :, None, :]
    x1, x2 = jnp.split(x, 2, axis=-1)
    return jnp.concatenate([x1 * cos - x2 * sin, x1 * sin + x2 * cos], axis=-1)


def _rope_2d(x):
    seq_len, d = x.shape[1], x.shape[-1]
    rows = seq_len // GRID_W
    row = jnp.repeat(jnp.arange(rows, dtype=jnp.float32), GRID_W)
    col = jnp.tile(jnp.arange(GRID_W, dtype=jnp.float32), rows)
    n_freq = d // 4
    inv = ROPE_THETA ** (-jnp.arange(n_freq, dtype=jnp.float32) / n_freq)
    x32 = x.astype(jnp.float32)
    half = d // 2
    xr = _rope_1d(x32[..., :half], row[:, None] * inv[None, :])
    xc = _rope_1d(x32[..., half:], col[:, None] * inv[None, :])
    return jnp.concatenate([xr, xc], axis=-1).astype(x.dtype)


def _attend(qb, k, v, sink=None, valid=None):
    s = jnp.einsum('bqhgd,bkhd->bhgqk', qb, k).astype(jnp.float32) * (HEAD_DIM ** -0.5)
    if valid is not None:
        s = jnp.where(valid, s, NEG_INF)
    m = jnp.max(s, axis=-1, keepdims=True)
    if sink is None:
        p = jnp.exp(s - m)
        denom = jnp.sum(p, axis=-1, keepdims=True)
    else:
        sk = sink.astype(jnp.float32)[None, :, :, None, None]
        m = jnp.maximum(m, sk)
        p = jnp.exp(s - m)
        denom = jnp.sum(p, axis=-1, keepdims=True) + jnp.exp(sk - m)
    p = (p / denom).astype(v.dtype)
    return jnp.einsum('bhgqk,bkhd->bqhgd', p, v)


def _blocked(q, n_kv, fn):
    bsz, seq_len, hq, d = q.shape
    nb = seq_len // Q_BLOCK
    qb = q.reshape(bsz, nb, Q_BLOCK, n_kv, hq // n_kv, d).transpose(1, 0, 2, 3, 4, 5)
    out = lax.map(lambda a: fn(a[0], a[1]), (qb, jnp.arange(nb)))
    return out.transpose(1, 0, 2, 3, 4, 5).reshape(bsz, seq_len, hq * d)


def _retention_scan(q, k, v, log_gamma, s0):
    bsz, seq_len, n_h, _ = q.shape
    dv = v.shape[-1]
    nc = seq_len // RET_CHUNK

    def chunks(t):
        return t.astype(jnp.float32).reshape(bsz, nc, RET_CHUNK, n_h, t.shape[-1]).transpose(1, 0, 3, 2, 4)

    pos = jnp.arange(RET_CHUNK, dtype=jnp.float32)
    diff = pos[:, None] - pos[None, :]
    lg = log_gamma[:, None, None]
    decay = jnp.exp(jnp.where(diff[None] >= 0, diff[None] * lg, NEG_INF))
    q_decay = jnp.exp((pos + 1.0)[None, :] * log_gamma[:, None])[..., None]
    k_decay = jnp.exp((RET_CHUNK - 1.0 - pos)[None, :] * log_gamma[:, None])[..., None]
    chunk_decay = jnp.exp(RET_CHUNK * log_gamma)[:, None, None]

    def step(s, xs):
        qc, kc, vc = xs
        att = jnp.einsum('bhid,bhjd->bhij', qc, kc) * decay
        o = jnp.einsum('bhij,bhje->bhie', att, vc) + jnp.einsum('bhid,bhde->bhie', qc * q_decay, s)
        s = chunk_decay * s + jnp.einsum('bhjd,bhje->bhde', kc * k_decay, vc)
        return s, o

    s_final, o = lax.scan(step, s0.astype(jnp.float32), (chunks(q), chunks(k), chunks(v)))
    o = o.transpose(1, 0, 3, 2, 4).reshape(bsz, seq_len, n_h, dv)
    return o.astype(v.dtype), s_final.astype(s0.dtype)


def _attn_mixer(h, w_in, q_gain, k_gain, sink, w_out, ctx):
    bsz, seq_len, _ = h.shape
    qa, ka, va, qs, ks, vs = jnp.split(h @ w_in, ATTN_SPLITS, axis=-1)
    qa = _rms(qa.reshape(bsz, seq_len, HQ_ATTN, HEAD_DIM), q_gain)
    ka = _rms(ka.reshape(bsz, seq_len, KV_ATTN, HEAD_DIM), k_gain)
    va = va.reshape(bsz, seq_len, KV_ATTN, HEAD_DIM)
    qs = qs.reshape(bsz, seq_len, HQ_SWA, HEAD_DIM)
    ks = ks.reshape(bsz, seq_len, KV_SWA, HEAD_DIM)
    vs = vs.reshape(bsz, seq_len, KV_SWA, HEAD_DIM)
    sink_g = sink.reshape(KV_SWA, HQ_SWA // KV_SWA)
    if ctx is None:
        out_a = _blocked(qa, KV_ATTN, lambda qb, idx: _attend(qb, ka, va))
        out_s = _blocked(qs, KV_SWA, lambda qb, idx: _attend(qb, ks, vs, sink=sink_g))
        state = (ka, va, ks, vs)
    else:
        ka_ctx, va_ctx, ks_ctx, vs_ctx = ctx
        qa, ka, qs, ks = _rope_2d(qa), _rope_2d(ka), _rope_2d(qs), _rope_2d(ks)
        k_all = jnp.concatenate([ka_ctx, ka], axis=1)
        v_all = jnp.concatenate([va_ctx, va], axis=1)
        out_a = _blocked(qa, KV_ATTN, lambda qb, idx: _attend(qb, k_all, v_all))
        pad = ((0, 0), (WINDOW, WINDOW), (0, 0), (0, 0))
        ks_pad = jnp.pad(ks, pad)
        vs_pad = jnp.pad(vs, pad)
        band = Q_BLOCK + 2 * WINDOW
        ctx_valid = jnp.ones((Q_BLOCK, ks_ctx.shape[1]), dtype=bool)

        def band_block(qb, idx):
            start = idx * Q_BLOCK
            kb = lax.dynamic_slice_in_dim(ks_pad, start, band, axis=1)
            vb = lax.dynamic_slice_in_dim(vs_pad, start, band, axis=1)
            q_pos = start + jnp.arange(Q_BLOCK)
            k_pos = start - WINDOW + jnp.arange(band)
            valid = ((jnp.abs(q_pos[:, None] - k_pos[None, :]) <= WINDOW)
                     & (k_pos >= 0)[None, :] & (k_pos < seq_len)[None, :])
            return _attend(qb, jnp.concatenate([ks_ctx, kb], axis=1), jnp.concatenate([vs_ctx, vb], axis=1),
                           sink=sink_g, valid=jnp.concatenate([ctx_valid, valid], axis=1))

        out_s = _blocked(qs, KV_SWA, band_block)
        state = ()
    return jnp.concatenate([out_a, out_s], axis=-1) @ w_out, state


def _ret_mixer(h, w_in, decay_fwd, decay_bwd, gn_gain, w_out, ctx):
    bsz, seq_len, _ = h.shape
    q, k, v, g = jnp.split(h @ w_in, RET_SPLITS, axis=-1)
    q = q.reshape(bsz, seq_len, RET_HEADS, RET_DK)
    k = k.reshape(bsz, seq_len, RET_HEADS, RET_DK)
    v = v.reshape(bsz, seq_len, RET_HEADS, RET_DV)
    if ctx is None:
        s0_f = jnp.zeros((bsz, RET_HEADS, RET_DK, RET_DV), h.dtype)
        s0_b = jnp.zeros((bsz, RET_HEADS, RET_DK, RET_DV), h.dtype)
    else:
        q, k = _rope_2d(q), _rope_2d(k)
        s0_f, s0_b = ctx
    k = k * (RET_DK ** -0.5)
    o_f, s_f = _retention_scan(q, k, v, jax.nn.log_sigmoid(decay_fwd.astype(jnp.float32)), s0_f)
    o_b, s_b = _retention_scan(jnp.flip(q, 1), jnp.flip(k, 1), jnp.flip(v, 1),
                               jax.nn.log_sigmoid(decay_bwd.astype(jnp.float32)), s0_b)
    o = _rms(o_f + jnp.flip(o_b, 1), gn_gain).reshape(bsz, seq_len, RET_V_W)
    out = (jax.nn.silu(g) * o) @ w_out
    state = (s_f, s_b) if ctx is None else ()
    return out, state


def _layer(x, cond, ada_w, ada_b, norm_mix, norm_mlp, mlp_w1, mlp_w2, mixer):
    mod = jax.nn.silu(cond) @ ada_w + ada_b
    sh1, sc1, g1, sh2, sc2, g2 = jnp.split(mod[..., None, :], ADA_CHUNKS, axis=-1)
    y, state = mixer(_rms(x, norm_mix) * (1.0 + sc1) + sh1)
    x = x + g1 * y
    h = _rms(x, norm_mlp) * (1.0 + sc2) + sh2
    x = x + g2 * (jnp.square(jax.nn.relu(h @ mlp_w1)) @ mlp_w2)
    return x, state


def setup_inputs(seed: int = 0) -> dict:
    key = jax.random.key(seed)
    keys = jax.random.split(key, 40)
    counter = [0]

    def nrm(shape, scale=1.0):
        sub = keys[counter[0]]
        counter[0] += 1
        return scale * jax.random.normal(sub, shape, jnp.float32)

    def gain(shape):
        return 1.0 + 0.1 * nrm(shape)

    decay_init = jnp.log(2.0 ** (5.0 + jnp.arange(RET_HEADS, dtype=jnp.float32)) - 1.0)
    return {
        'x_prompt': nrm((BATCH, SEQ, D_MODEL)),
        'x_sample': nrm((DEC_BATCH, DEC_SEQ, D_MODEL)),
        'c': nrm((DEC_BATCH, D_MODEL)),
        'cache_l0_attn_k': nrm((DEC_BATCH, PAST_LEN, KV_ATTN, HEAD_DIM)),
        'cache_l0_attn_v': nrm((DEC_BATCH, PAST_LEN, KV_ATTN, HEAD_DIM)),
        'cache_l0_swa_k': nrm((DEC_BATCH, PAST_LEN, KV_SWA, HEAD_DIM)),
        'cache_l0_swa_v': nrm((DEC_BATCH, PAST_LEN, KV_SWA, HEAD_DIM)),
        'state_l1_ret_fwd': nrm((DEC_BATCH, RET_HEADS, RET_DK, RET_DV), 0.5),
        'state_l1_ret_bwd': nrm((DEC_BATCH, RET_HEADS, RET_DK, RET_DV), 0.5),
        'c_ctx': nrm((D_MODEL,)),
        'l0_ada_w': nrm((D_MODEL, ADA_CHUNKS * D_MODEL), 0.5 * D_MODEL ** -0.5),
        'l0_ada_b': nrm((ADA_CHUNKS * D_MODEL,), 0.02),
        'l0_norm_mix': gain((D_MODEL,)),
        'l0_norm_mlp': gain((D_MODEL,)),
        'l0_w_in': nrm((D_MODEL, ATTN_IN_W), D_MODEL ** -0.5),
        'l0_q_norm': gain((HEAD_DIM,)),
        'l0_k_norm': gain((HEAD_DIM,)),
        'l0_sink': nrm((HQ_SWA,), 0.5),
        'l0_w_out': nrm((ATTN_OUT_W, D_MODEL), ATTN_OUT_W ** -0.5),
        'l0_mlp_w1': nrm((D_MODEL, D_FF), D_MODEL ** -0.5),
        'l0_mlp_w2': nrm((D_FF, D_MODEL), D_FF ** -0.5),
        'l1_ada_w': nrm((D_MODEL, ADA_CHUNKS * D_MODEL), 0.5 * D_MODEL ** -0.5),
        'l1_ada_b': nrm((ADA_CHUNKS * D_MODEL,), 0.02),
        'l1_norm_mix': gain((D_MODEL,)),
        'l1_norm_mlp': gain((D_MODEL,)),
        'l1_w_in': nrm((D_MODEL, RET_IN_W), D_MODEL ** -0.5),
        'l1_ret_decay_fwd': decay_init + nrm((RET_HEADS,), 0.1),
        'l1_ret_decay_bwd': decay_init + nrm((RET_HEADS,), 0.1),
        'l1_ret_gn': gain((RET_HEADS, RET_DV)),
        'l1_w_out': nrm((RET_V_W, D_MODEL), RET_V_W ** -0.5),
        'l1_mlp_w1': nrm((D_MODEL, D_FF), D_MODEL ** -0.5),
        'l1_mlp_w2': nrm((D_FF, D_MODEL), D_FF ** -0.5),
        'final_norm': gain((D_MODEL,)),
    }


def reference(x_prompt, x_sample, c, cache_l0_attn_k, cache_l0_attn_v, cache_l0_swa_k, cache_l0_swa_v,
              state_l1_ret_fwd, state_l1_ret_bwd, c_ctx,
              l0_ada_w, l0_ada_b, l0_norm_mix, l0_norm_mlp, l0_w_in, l0_q_norm, l0_k_norm, l0_sink, l0_w_out,
              l0_mlp_w1, l0_mlp_w2,
              l1_ada_w, l1_ada_b, l1_norm_mix, l1_norm_mlp, l1_w_in, l1_ret_decay_fwd, l1_ret_decay_bwd,
              l1_ret_gn, l1_w_out, l1_mlp_w1, l1_mlp_w2, final_norm):
    layer_common = [
        (l0_ada_w, l0_ada_b, l0_norm_mix, l0_norm_mlp, l0_mlp_w1, l0_mlp_w2),
        (l1_ada_w, l1_ada_b, l1_norm_mix, l1_norm_mlp, l1_mlp_w1, l1_mlp_w2),
    ]
    layer_mixer = [
        functools.partial(_attn_mixer, w_in=l0_w_in, q_gain=l0_q_norm, k_gain=l0_k_norm,
                          sink=l0_sink, w_out=l0_w_out),
        functools.partial(_ret_mixer, w_in=l1_w_in, decay_fwd=l1_ret_decay_fwd, decay_bwd=l1_ret_decay_bwd,
                          gn_gain=l1_ret_gn, w_out=l1_w_out),
    ]
    layer_cache = [
        (cache_l0_attn_k, cache_l0_attn_v, cache_l0_swa_k, cache_l0_swa_v),
        (state_l1_ret_fwd, state_l1_ret_bwd),
    ]
    x_p, x_s = x_prompt, x_sample
    new_state = []
    for layer in range(DEPTH):
        mixer = layer_mixer[layer]
        x_p, st = _layer(x_p, c_ctx, *layer_common[layer], mixer=functools.partial(mixer, ctx=None))
        new_state.extend(st)
        x_s, _ = _layer(x_s, c, *layer_common[layer], mixer=functools.partial(mixer, ctx=layer_cache[layer]))
    y_prompt = _rms(x_p, final_norm)
    y_sample = _rms(x_s, final_norm)
    new_l0_attn_k, new_l0_attn_v, new_l0_swa_k, new_l0_swa_v, new_l1_ret_fwd, new_l1_ret_bwd = new_state
    return (y_prompt, y_sample, new_l0_attn_k, new_l0_attn_v, new_l0_swa_k, new_l0_swa_v, new_l1_ret_fwd, new_l1_ret_bwd)
```

```cpp
#include <hip/hip_runtime.h>
#include <hip/hip_cooperative_groups.h>
#include <cstdio>
namespace cg = cooperative_groups;

#ifndef MULTI_LAUNCH
#define MULTI_LAUNCH 0
#endif

typedef unsigned short u16;
typedef __attribute__((ext_vector_type(8))) short bf16x8;
typedef __attribute__((ext_vector_type(16))) float f32x16;
typedef __attribute__((ext_vector_type(4))) unsigned u32x4;

#define DI __device__ __forceinline__
#define NT 36864
#define RROWS 12288
#define EPSF 1e-6f
#define LOG2E 1.4426950408889634f

#define O_AK 37748736L
#define O_AV 38273024L
#define O_SK 38797312L
#define O_SV 39321600L
#define O_RF 39845888L
#define O_RB 48234496L

struct Params {
  const float *x_prompt, *x_sample, *c, *ck_a, *cv_a, *ck_s, *cv_s, *st_f, *st_b, *c_ctx;
  const float *ada_w[2], *ada_b[2], *norm_mix[2], *norm_mlp[2];
  const float *w_in0, *q_norm, *k_norm, *sink, *w_out0;
  const float *w_in1, *dec_f, *dec_b, *gn, *w_out1;
  const float *w1[2], *w2[2];
  const float *final_norm;
  float* out;
  u16 *wt_in0, *wt_out0, *wt_in1, *wt_out1, *wt_w1[2], *wt_w2[2];
  float* mod;
  float2* tab0;
  float2* tab1;
  float* rowss;
  unsigned* bar;
  u16* H;
  u16 *Q0, *ATT;
  u16 *KS[2], *VTS[2];
  u16 *KP[2], *VTP[2];
  u16* FF;
  float* PT;
  u16 *Qr, *Kr, *KTf, *KTb, *VTr, *SG, *KV, *ATTb, *Ob;
};

typedef __attribute__((ext_vector_type(2))) float f32x2_t;
typedef __attribute__((ext_vector_type(2))) __bf16 bf16x2_t;
DI unsigned pack2(float a, float b) { f32x2_t v; v.x = a; v.y = b; bf16x2_t r = __builtin_convertvector(v, bf16x2_t); return __builtin_bit_cast(unsigned, r); }
DI u16 f2bf(float f) { return (u16)(pack2(f, 0.f) & 0xffffu); }
DI float ex2(float x) { return __builtin_amdgcn_exp2f(x); }
#define SB0 __builtin_amdgcn_sched_barrier(0)
DI float bf2f(u16 h) { return __uint_as_float(((unsigned)h) << 16); }
#define NTH 512
#define LDS3 __attribute__((address_space(3)))

DI void rowinfo(int row, int& mi, int& b, int& pos, bool& smp) {
  if (row < 4096) { smp = false; b = row >> 8; pos = row & 255; mi = 0; }
  else { int s = row - 4096; smp = true; b = s >> 12; pos = s & 4095; mi = 1 + b; }
}

DI void zero_acc(f32x16 (&acc)[4][2]) {
#pragma unroll
  for (int a = 0; a < 4; ++a)
#pragma unroll
    for (int b = 0; b < 2; ++b)
#pragma unroll
      for (int r = 0; r < 16; ++r) acc[a][b][r] = 0.f;
}

DI void gemm256(f32x16 (&acc)[4][2], const u16* __restrict__ A, long lda, const u16* __restrict__ B, long ldb, int K, char* smem) {
  int tz_; asm volatile("v_mov_b32 %0, 0" : "=v"(tz_));
  const int t = threadIdx.x + tz_, lane = t & 63, wid = t >> 6, wr = wid >> 2, wc = wid & 3;
  const int lrow = t >> 3, gslot = (t & 7) ^ ((lrow >> 1) & 7);
  const unsigned voa = ((unsigned)lrow * (unsigned)lda + gslot * 8) * 2u;
  const unsigned vob = ((unsigned)lrow * (unsigned)ldb + gslot * 8) * 2u;
  const char* Ab = (const char*)A;
  const char* Bb = (const char*)B;
  char* sa = smem;
  char* sb = smem + 65536;
  const int nk = K >> 6;
#define G256_STAGE(buf_, kt_)                                                                                               \
  _Pragma("unroll") for (int i = 0; i < 4; ++i) {                                                                           \
    __builtin_amdgcn_global_load_lds((const unsigned*)(Ab + ((long)(64 * i) * lda + (kt_) * 64) * 2 + voa),                 \
                                     (LDS3 unsigned*)(sa + (buf_) * 32768 + i * 8192 + wid * 1024), 16, 0, 0);              \
    __builtin_amdgcn_global_load_lds((const unsigned*)(Bb + ((long)(64 * i) * ldb + (kt_) * 64) * 2 + vob),                 \
                                     (LDS3 unsigned*)(sb + (buf_) * 32768 + i * 8192 + wid * 1024), 16, 0, 0);              \
  }
  G256_STAGE(0, 0)
  asm volatile("s_waitcnt vmcnt(0)" ::: "memory");
  __syncthreads();
  const int r31 = lane & 31, h = lane >> 5, sw = (lane >> 1) & 7;
  const int aoff = (wr * 128 + r31) * 128;
  const int boff = (wc * 64 + r31) * 128;
  for (int kt = 0; kt < nk; ++kt) {
    const int buf = kt & 1;
    if (kt + 1 < nk) { G256_STAGE(buf ^ 1, kt + 1) }
    const char* ca = sa + buf * 32768 + aoff;
    const char* cb = sb + buf * 32768 + boff;
    bf16x8 af[2][4], bfr[2][2];
    {
      const int so = ((0 * 2 + h) ^ sw) << 4;
      bfr[0][0] = *(const bf16x8*)(cb + so);
      bfr[0][1] = *(const bf16x8*)(cb + 4096 + so);
#pragma unroll
      for (int tm = 0; tm < 4; ++tm) af[0][tm] = *(const bf16x8*)(ca + tm * 4096 + so);
    }
#pragma unroll
    for (int ks = 0; ks < 4; ++ks) {
      const int cur = ks & 1, nxt = cur ^ 1;
      if (ks < 3) {
        const int so = (((ks + 1) * 2 + h) ^ sw) << 4;
        bfr[nxt][0] = *(const bf16x8*)(cb + so);
        bfr[nxt][1] = *(const bf16x8*)(cb + 4096 + so);
#pragma unroll
        for (int tm = 0; tm < 4; ++tm) af[nxt][tm] = *(const bf16x8*)(ca + tm * 4096 + so);
      }
      SB0;
      __builtin_amdgcn_s_setprio(1);
#pragma unroll
      for (int tm = 0; tm < 4; ++tm) {
        acc[tm][0] = __builtin_amdgcn_mfma_f32_32x32x16_bf16(af[cur][tm], bfr[cur][0], acc[tm][0], 0, 0, 0);
        acc[tm][1] = __builtin_amdgcn_mfma_f32_32x32x16_bf16(af[cur][tm], bfr[cur][1], acc[tm][1], 0, 0, 0);
      }
      __builtin_amdgcn_s_setprio(0);
      SB0;
    }
    asm volatile("s_waitcnt vmcnt(0)" ::: "memory");
    __syncthreads();
  }
}

#define TLW const int t = threadIdx.x, wid = t >> 6, wr = wid >> 2, wc = wid & 3; (void)t; (void)wr; (void)wc;
#define OPQ_LANE int lane; { int z_; asm volatile("v_mov_b32 %0, 0" : "=v"(z_)); lane = (threadIdx.x + z_) & 63; } (void)lane;
#define CROW(tm, r) (wr * 128 + (tm) * 32 + ((r) & 3) + 8 * ((r) >> 2) + 4 * (lane >> 5))
#define CCOL(tn) (wc * 64 + (tn) * 32 + (lane & 31))

#define DPPF(x_, ctrl_, rmask_) __int_as_float(__builtin_amdgcn_update_dpp(0, __float_as_int(x_), ctrl_, rmask_, 0xf, false))
DI float red32_dpp(float x) {
  x += DPPF(x, 0xB1, 0xF);
  x += DPPF(x, 0x4E, 0xF);
  x += DPPF(x, 0x141, 0xF);
  x += DPPF(x, 0x140, 0xF);
  x += DPPF(x, 0x142, 0xA);
  return x;
}
DI float xhalf_max(float x) { auto r = __builtin_amdgcn_permlane32_swap(__float_as_uint(x), __float_as_uint(x), false, false); return fmaxf(__uint_as_float(r[0]), __uint_as_float(r[1])); }
DI float xhalf_sum(float x) { auto r = __builtin_amdgcn_permlane32_swap(__float_as_uint(x), __float_as_uint(x), false, false); return __uint_as_float(r[0]) + __uint_as_float(r[1]); }
DI float rl31(float x) { return __int_as_float(__builtin_amdgcn_readlane(__float_as_int(x), 31)); }
DI float rl63(float x) { return __int_as_float(__builtin_amdgcn_readlane(__float_as_int(x), 63)); }
DI float red32(float v) {
  v += __shfl_xor(v, 1); v += __shfl_xor(v, 2); v += __shfl_xor(v, 4); v += __shfl_xor(v, 8); v += __shfl_xor(v, 16);
  return v;
}

DI int perm_slot(int n, int perm) {
  if (perm == 1) {
    int hc = n >> 6, d = n & 63, nc; bool isv = false;
    if (hc < 8) nc = hc; else if (hc < 10) nc = 16 + (hc - 8); else if (hc < 12) { nc = 20 + (hc - 10); isv = true; }
    else if (hc < 20) nc = 8 + (hc - 12); else if (hc < 22) nc = 18 + (hc - 20); else { nc = 22 + (hc - 22); isv = true; }
    int half = d >> 5, x = (d >> 4) & 1, f = d & 15;
    return nc * 64 + (isv ? d : (x * 32 + half * 16 + f));
  } else if (perm == 2) {
    if (n >= 2048) return n;
    int d = n & 255, half = d >> 7, x = (d >> 6) & 1, f = d & 63;
    return (n & ~255) + half * 128 + (f >> 5) * 64 + x * 32 + (f & 31);
  }
  return n;
}

DI void transpose_weight(const float* __restrict__ W, int K, int N, u16* __restrict__ Wt, int perm, char* smem) {
  float* tile = (float*)smem;
  const int t = threadIdx.x;
  const int ntn = N >> 6;
  const int tiles = (K >> 6) * ntn;
  for (int it = blockIdx.x; it < tiles; it += 2 * gridDim.x) {
    const int it2 = it + gridDim.x;
    const bool has2 = it2 < tiles;
    const int nt0 = it % ntn, kt0 = it / ntn;
    const int nt1 = has2 ? it2 % ntn : nt0, kt1 = has2 ? it2 / ntn : kt0;
    float va[8], vb[8];
#pragma unroll
    for (int i = 0; i < 8; ++i) {
      const int r = (t >> 6) + 8 * i, cidx = t & 63;
      va[i] = W[(size_t)(kt0 * 64 + r) * N + nt0 * 64 + cidx];
      vb[i] = W[(size_t)(kt1 * 64 + r) * N + nt1 * 64 + cidx];
    }
#pragma unroll
    for (int i = 0; i < 8; ++i) {
      const int r = (t >> 6) + 8 * i, cidx = t & 63;
      tile[r * 65 + cidx] = va[i];
      tile[4160 + r * 65 + cidx] = vb[i];
    }
    __syncthreads();
#pragma unroll
    for (int i = 0; i < 4; ++i) {
      const int n = (t >> 5) + 16 * i, kp = t & 31;
      const unsigned v0 = pack2(tile[(2 * kp) * 65 + n], tile[(2 * kp + 1) * 65 + n]);
      const unsigned v1 = pack2(tile[4160 + (2 * kp) * 65 + n], tile[4160 + (2 * kp + 1) * 65 + n]);
      *(unsigned*)(Wt + (size_t)perm_slot(nt0 * 64 + n, perm) * K + kt0 * 64 + 2 * kp) = v0;
      if (has2) *(unsigned*)(Wt + (size_t)perm_slot(nt1 * 64 + n, perm) * K + kt1 * 64 + 2 * kp) = v1;
    }
    __syncthreads();
  }
}

DI void prep_phase(const Params& p, char* smem) {
  const int t = threadIdx.x;
  transpose_weight(p.w_in0, 1024, 1536, p.wt_in0, 1, smem);
  transpose_weight(p.w_out0, 1024, 1024, p.wt_out0, 0, smem);
  transpose_weight(p.w_in1, 1024, 6144, p.wt_in1, 2, smem);
  transpose_weight(p.w_out1, 2048, 1024, p.wt_out1, 0, smem);
  for (int l = 0; l < 2; ++l) {
    transpose_weight(p.w1[l], 1024, 4096, p.wt_w1[l], 0, smem);
    transpose_weight(p.w2[l], 4096, 1024, p.wt_w2[l], 0, smem);
  }
  {
    float* sc = (float*)smem;
    float* red = (float*)(smem + 36864);
    for (int it = blockIdx.x; it < 192; it += gridDim.x) {
      const int layer = it / 96, cb = it % 96;
      for (int i = t; i < 9216; i += NTH) {
        int r = i >> 10, k = i & 1023;
        float v = (r == 0) ? p.c_ctx[k] : p.c[(r - 1) * 1024 + k];
        sc[i] = v / (1.f + __expf(-v));
      }
      __syncthreads();
      const int n = cb * 64 + (t & 63), kg = t >> 6;
      float a[9];
#pragma unroll
      for (int r = 0; r < 9; ++r) a[r] = 0.f;
      const float* w = p.ada_w[layer] + (long)(kg * 128) * 6144 + n;
#pragma unroll 8
      for (int k = 0; k < 128; ++k) {
        float wv = w[(long)k * 6144];
#pragma unroll
        for (int r = 0; r < 9; ++r) a[r] += sc[r * 1024 + kg * 128 + k] * wv;
      }
#pragma unroll
      for (int r = 0; r < 9; ++r) red[(kg * 9 + r) * 64 + (t & 63)] = a[r];
      __syncthreads();
      for (int i = t; i < 576; i += NTH) {
        int r = i >> 6, cidx = i & 63;
        float s = 0.f;
#pragma unroll
        for (int g = 0; g < 8; ++g) s += red[(g * 9 + r) * 64 + cidx];
        int nn = cb * 64 + cidx;
        p.mod[((long)layer * 9 + r) * 6144 + nn] = s + p.ada_b[layer][nn];
      }
      __syncthreads();
    }
  }
  {
    int gz_ = t; asm volatile("" : "+v"(gz_));
    const int gid = blockIdx.x * NTH + gz_, gsz = gridDim.x * NTH;
    for (int i = gid; i < 2 * 524288; i += gsz) {
      int kind = (int)(i >> 19); int j = (int)(i & 524287);
      int d = j & 63, key = (j >> 6) & 511, kvh = (j >> 15) & 1, b = j >> 16;
      const float* ck = kind ? p.ck_s : p.ck_a;
      p.KS[kind][((long)(b * 2 + kvh) * 4608 + key) * 64 + d] = f2bf(ck[((long)(b * 512 + key) * 2 + kvh) * 64 + d]);
      int key2 = j & 511, e = (j >> 9) & 63;
      const float* cv = kind ? p.cv_s : p.cv_a;
      p.VTS[kind][((long)(b * 2 + kvh) * 64 + e) * 4608 + key2] = f2bf(cv[((long)(b * 512 + key2) * 2 + kvh) * 64 + e]);
    }
    for (int i = gid; i < 1024 + 4096; i += gsz) {
      int pos, f; double cbase;
      if (i < 1024) { pos = (int)(i >> 4); f = (int)(i & 15); cbase = 0.5623413251903491; }
      else { int j = (int)(i - 1024); pos = j >> 6; f = j & 63; cbase = 0.8659643233600653; }
      double inv = 1.0;
      for (int q = 0; q < f; ++q) inv *= cbase;
      double ang = (double)pos * inv;
      const double TWO_PI = 6.283185307179586476925;
      double n = rint(ang / TWO_PI);
      double rr = ang - n * TWO_PI;
      double r2 = rr * rr;
      double sn = 0.0, cs = 0.0, ts = rr, tc = 1.0;
      for (int q = 0; q < 14; ++q) {
        cs += tc; sn += ts;
        tc = -tc * r2 / (double)((2 * q + 1) * (2 * q + 2));
        ts = -ts * r2 / (double)((2 * q + 2) * (2 * q + 3));
      }
      float2 v; v.x = (float)cs; v.y = (float)sn;
      if (i < 1024) p.tab0[i] = v; else p.tab1[i - 1024] = v;
    }
  }
}

DI void norm_phase(const Params& p, int layer, int which, bool from_input, bool tailfix = false) {
  int tz_; asm volatile("v_mov_b32 %0, 0" : "=v"(tz_));
  const int tt_ = threadIdx.x + tz_;
  const int wave = tt_ >> 6, lane = tt_ & 63;
  for (int pidx = blockIdx.x * 8 + wave; pidx < NT / 2; pidx += gridDim.x * 8) {
    const int row = 2 * pidx;
    const float* x = from_input ? (row < 4096 ? p.x_prompt + (size_t)row * 1024 : p.x_sample + (size_t)(row - 4096) * 1024)
                                : p.out + (size_t)row * 1024;
    float4 va[4], vb[4], g[4], sc[4], sh[4];
#pragma unroll
    for (int i = 0; i < 4; ++i) {
      va[i] = ((const float4*)x)[lane + 64 * i];
      vb[i] = ((const float4*)(x + 1024))[lane + 64 * i];
    }
    if (tailfix && row >= 32768) {
#pragma unroll
      for (int q = 0; q < 3; ++q) {
        const float* pp = p.PT + (size_t)q * 4096 * 1024 + (size_t)(row - 32768) * 1024;
#pragma unroll
        for (int i = 0; i < 4; ++i) {
          const float4 a = ((const float4*)pp)[lane + 64 * i], b2 = ((const float4*)(pp + 1024))[lane + 64 * i];
          va[i].x += a.x; va[i].y += a.y; va[i].z += a.z; va[i].w += a.w;
          vb[i].x += b2.x; vb[i].y += b2.y; vb[i].z += b2.z; vb[i].w += b2.w;
        }
      }
      if (which != 2) {
#pragma unroll
        for (int i = 0; i < 4; ++i) {
          ((float4*)(p.out + (size_t)row * 1024))[lane + 64 * i] = va[i];
          ((float4*)(p.out + (size_t)(row + 1) * 1024))[lane + 64 * i] = vb[i];
        }
      }
    }
    if (which == 2) {
#pragma unroll
      for (int i = 0; i < 4; ++i) g[i] = ((const float4*)p.final_norm)[lane + 64 * i];
    } else {
      int mi, b, pos; bool smp; rowinfo(row, mi, b, pos, smp);
      const float* gain = which ? p.norm_mlp[layer] : p.norm_mix[layer];
      const float* mod = p.mod + ((size_t)layer * 9 + mi) * 6144;
      const float* shp = mod + (which ? 3 : 0) * 1024;
      const float* scp = mod + (which ? 4 : 1) * 1024;
#pragma unroll
      for (int i = 0; i < 4; ++i) {
        g[i] = ((const float4*)gain)[lane + 64 * i];
        sc[i] = ((const float4*)scp)[lane + 64 * i];
        sh[i] = ((const float4*)shp)[lane + 64 * i];
      }
    }
    SB0;
    float ssa = 0.f, ssb = 0.f;
#pragma unroll
    for (int i = 0; i < 4; ++i) {
      ssa += va[i].x * va[i].x + va[i].y * va[i].y + va[i].z * va[i].z + va[i].w * va[i].w;
      ssb += vb[i].x * vb[i].x + vb[i].y * vb[i].y + vb[i].z * vb[i].z + vb[i].w * vb[i].w;
    }
    { const float sd = red32_dpp(ssa); ssa = rl31(sd) + rl63(sd); }
    { const float sd = red32_dpp(ssb); ssb = rl31(sd) + rl63(sd); }
    const float ra = rsqrtf(ssa * (1.f / 1024.f) + EPSF), rb = rsqrtf(ssb * (1.f / 1024.f) + EPSF);
    if (which == 2) {
#pragma unroll
      for (int i = 0; i < 4; ++i) {
        float4 oa, ob;
        oa.x = va[i].x * ra * g[i].x; oa.y = va[i].y * ra * g[i].y; oa.z = va[i].z * ra * g[i].z; oa.w = va[i].w * ra * g[i].w;
        ob.x = vb[i].x * rb * g[i].x; ob.y = vb[i].y * rb * g[i].y; ob.z = vb[i].z * rb * g[i].z; ob.w = vb[i].w * rb * g[i].w;
        ((float4*)(p.out + (size_t)row * 1024))[lane + 64 * i] = oa;
        ((float4*)(p.out + (size_t)(row + 1) * 1024))[lane + 64 * i] = ob;
      }
    } else {
#pragma unroll
      for (int i = 0; i < 4; ++i) {
        const float m0 = g[i].x * (1.f + sc[i].x), m1 = g[i].y * (1.f + sc[i].y), m2 = g[i].z * (1.f + sc[i].z), m3 = g[i].w * (1.f + sc[i].w);
        uint2 pa, pb;
        pa.x = pack2(va[i].x * ra * m0 + sh[i].x, va[i].y * ra * m1 + sh[i].y);
        pa.y = pack2(va[i].z * ra * m2 + sh[i].z, va[i].w * ra * m3 + sh[i].w);
        pb.x = pack2(vb[i].x * rb * m0 + sh[i].x, vb[i].y * rb * m1 + sh[i].y);
        pb.y = pack2(vb[i].z * rb * m2 + sh[i].z, vb[i].w * rb * m3 + sh[i].w);
        *(uint2*)(p.H + (size_t)row * 1024 + (lane + 64 * i) * 4) = pa;
        *(uint2*)(p.H + (size_t)(row + 1) * 1024 + (lane + 64 * i) * 4) = pb;
      }
    }
  }
}

DI void in0_phase(const Params& p, char* smem) {
  TLW
  for (int it = blockIdx.x; it < 144 * 6; it += gridDim.x) {
    const int rt = it / 6, ct = it % 6;
    f32x16 acc[4][2];
    zero_acc(acc);
    OPQ_LANE
    int mi, b, pos0; bool smp; rowinfo(rt * 256, mi, b, pos0, smp); (void)mi;
    if (ct == 5) {
      gemm256(acc, p.wt_in0 + 1280L * 1024, 1024, p.H + (long)rt * 256 * 1024, 1024, 1024, smem);
      const int kind = wr;
      float* outv = p.out + (kind ? O_SV : O_AV);
#pragma unroll
      for (int tm = 0; tm < 4; ++tm) {
        SB0;
#pragma unroll
        for (int tn = 0; tn < 2; ++tn) {
          const int pos = pos0 + CCOL(tn);
          const int kvh = tm >> 1;
#pragma unroll
          for (int r = 0; r < 16; ++r) {
            const int e = (tm & 1) * 32 + (r & 3) + 8 * (r >> 2) + 4 * (lane >> 5);
            const float v = acc[tm][tn][r];
            if (smp) p.VTS[kind][((unsigned)(b * 2 + kvh) * 64 + e) * 4608 + 512 + pos] = f2bf(v);
            else {
              p.VTP[kind][((unsigned)(b * 2 + kvh) * 64 + e) * 256 + pos] = f2bf(v);
              outv[((unsigned)(b * 256 + pos) * 2 + kvh) * 64 + e] = v;
            }
          }
        }
      }
    } else {
      gemm256(acc, p.H + (long)rt * 256 * 1024, 1024, p.wt_in0 + (long)ct * 256 * 1024, 1024, 1024, smem);
      const int nc = ct * 4 + wc;
      const bool isq = nc < 16;
      const int kind = (nc >= 8 && nc < 16) || nc >= 18;
      const bool donorm = nc < 8 || nc == 16 || nc == 17;
      const float* gain = nc < 8 ? p.q_norm : p.k_norm;
      const int half = (lane >> 4) & 1, f = lane & 15;
      const int d0 = half * 32 + f, d1 = d0 + 16;
      float g0 = 1.f, g1 = 1.f;
      if (donorm) { g0 = gain[d0]; g1 = gain[d1]; }
      float* outk = p.out + (kind ? O_SK : O_AK);
#pragma unroll
      for (int tm = 0; tm < 4; ++tm) {
        SB0;
        float2 csv[16];
#pragma unroll
        for (int r = 0; r < 16; ++r) {
          if ((r & 7) == 0 && smp) {
#pragma unroll
            for (int q = r; q < r + 8; ++q) {
              const int pos = pos0 + CROW(tm, q);
              csv[q] = p.tab0[(half ? (pos & 63) : (pos >> 6)) * 16 + f];
            }
          }
          if ((r & 3) == 0) SB0;
          const int row = rt * 256 + CROW(tm, r);
          const int pos = pos0 + CROW(tm, r);
          float x1 = acc[tm][0][r], x2 = acc[tm][1][r];
          if (donorm) {
            const float sd = red32_dpp(x1 * x1 + x2 * x2);
            const float slo = rl31(sd), shi = rl63(sd);
            const float ss = (lane >> 5) ? shi : slo;
            float rinv = rsqrtf(ss * (1.f / 64.f) + EPSF);
            x1 *= rinv * g0; x2 *= rinv * g1;
          }
          float o1 = x1, o2 = x2;
          if (smp) {
            const float2 cs = csv[r];
            o1 = x1 * cs.x - x2 * cs.y; o2 = x1 * cs.y + x2 * cs.x;
          }
          if (isq) {
            const int qcol = kind * 512 + (nc & 7) * 64;
            u16* q = p.Q0 + (unsigned)row * 1024 + qcol;
            q[d0] = f2bf(o1); q[d1] = f2bf(o2);
          } else {
            const int kvh = nc & 1;
            if (smp) {
              u16* k = p.KS[kind] + ((unsigned)(b * 2 + kvh) * 4608 + 512 + pos) * 64;
              k[d0] = f2bf(o1); k[d1] = f2bf(o2);
            } else {
              u16* k = p.KP[kind] + ((unsigned)(b * 2 + kvh) * 256 + pos) * 64;
              k[d0] = f2bf(o1); k[d1] = f2bf(o2);
              float* ko = outk + ((unsigned)(b * 256 + pos) * 2 + kvh) * 64;
              ko[d0] = o1; ko[d1] = o2;
            }
          }
        }
      }
    }
  }
}

DI void attn_phase(const Params& p, char* smem) {
  const int t = threadIdx.x, lane = t & 63, wid = t >> 6;
  const int r31 = lane & 31, h = lane >> 5;
  char* sk = smem;
  char* sv = smem + 16384;
  const float SC = 0.125f * LOG2E;
  for (int it = blockIdx.x; it < 1152; it += gridDim.x) {
    int kind, b, kvh, q0, Lk; bool smp;
    if (it < 1024) { smp = true; kind = it >> 9; int i = it & 511; q0 = (i & 31) * 128; kvh = (i >> 5) & 1; b = i >> 6; Lk = 4608; }
    else { smp = false; int i = it - 1024; kind = i >> 6; i &= 63; q0 = (i & 1) * 128; kvh = (i >> 1) & 1; b = i >> 2; Lk = 256; }
    const u16* Kb = smp ? p.KS[kind] + (long)(b * 2 + kvh) * 4608 * 64 : p.KP[kind] + (long)(b * 2 + kvh) * 256 * 64;
    const u16* Vb = smp ? p.VTS[kind] + (long)(b * 2 + kvh) * 64 * 4608 : p.VTP[kind] + (long)(b * 2 + kvh) * 64 * 256;
    int n1, n2, lo;
    if (!smp) { n1 = 4; n2 = 0; lo = 0; }
    else if (kind == 0) { n1 = 72; n2 = 0; lo = 0; }
    else {
      n1 = 8;
      int kl = q0 - 128; if (kl < 0) kl = 0;
      int kh = q0 + 255; if (kh > 4095) kh = 4095;
      lo = (512 + kl) & ~63;
      n2 = ((512 + kh) - lo) / 64 + 1;
    }
    const int ntiles = n1 + n2;
    const int qs0 = q0 + (wid >> 2) * 64;
    const int qrow0 = smp ? 4096 + b * 4096 + qs0 : b * 256 + qs0;
    const int head = kvh * 4 + (wid & 3);
    const int qcol = kind * 512 + head * 64;
    bf16x8 qf[2][4];
#pragma unroll
    for (int j = 0; j < 2; ++j)
#pragma unroll
      for (int ks = 0; ks < 4; ++ks) qf[j][ks] = *(const bf16x8*)(p.Q0 + (long)(qrow0 + j * 32 + r31) * 1024 + qcol + ks * 16 + 8 * h);
    float m[2], l[2];
    f32x16 O[2][2];
#pragma unroll
    for (int j = 0; j < 2; ++j) {
      m[j] = kind ? p.sink[head] * LOG2E : -1e30f;
      l[j] = (kind && h == 0) ? 1.f : 0.f;
#pragma unroll
      for (int r = 0; r < 16; ++r) { O[j][0][r] = 0.f; O[j][1][r] = 0.f; }
    }
    uint4 rk0, rv0;
    const int key_l = t >> 3, slot_l = t & 7;
    const int kw0 = key_l * 128 + ((slot_l ^ ((key_l >> 1) & 7)) << 4);
    const int vw0 = key_l * 136 + slot_l * 16;
#define ATT_GLOAD(base_)                                                              \
    rk0 = *(const uint4*)(Kb + (long)((base_) + key_l) * 64 + slot_l * 8);            \
    rv0 = *(const uint4*)(Vb + (long)(key_l) * Lk + (base_) + slot_l * 8);
#define ATT_SWRITE(nb_)                                                               \
    *(uint4*)(sk + (nb_) * 8192 + kw0) = rk0;                                         \
    *(uint2*)(sv + (nb_) * 8704 + vw0) = make_uint2(rv0.x, rv0.y);                    \
    *(uint2*)(sv + (nb_) * 8704 + vw0 + 8) = make_uint2(rv0.z, rv0.w);
    ATT_GLOAD(0)
    ATT_SWRITE(0)
    __syncthreads();
    for (int ti = 0; ti < ntiles; ++ti) {
      const int buf = ti & 1;
      const int base = ti < n1 ? ti * 64 : lo + (ti - n1) * 64;
      const bool masked = ti >= n1;
      if (ti + 1 < ntiles) {
        const int nbase = (ti + 1) < n1 ? (ti + 1) * 64 : lo + (ti + 1 - n1) * 64;
        ATT_GLOAD(nbase)
      }
      const char* ck = sk + buf * 8192;
      const char* cv = sv + buf * 8704;
      f32x16 s[2][2];
#pragma unroll
      for (int j = 0; j < 2; ++j)
#pragma unroll
        for (int r = 0; r < 16; ++r) { s[j][0][r] = 0.f; s[j][1][r] = 0.f; }
#pragma unroll
      for (int sub = 0; sub < 2; ++sub)
#pragma unroll
        for (int ks = 0; ks < 4; ++ks) {
          bf16x8 kf = *(const bf16x8*)(ck + (sub * 32 + r31) * 128 + (((ks * 2 + h) ^ ((r31 >> 1) & 7)) << 4));
          s[0][sub] = __builtin_amdgcn_mfma_f32_32x32x16_bf16(kf, qf[0][ks], s[0][sub], 0, 0, 0);
          s[1][sub] = __builtin_amdgcn_mfma_f32_32x32x16_bf16(kf, qf[1][ks], s[1][sub], 0, 0, 0);
        }
      if (masked) {
#pragma unroll
        for (int j = 0; j < 2; ++j)
#pragma unroll
          for (int sub = 0; sub < 2; ++sub)
#pragma unroll
            for (int r = 0; r < 16; ++r) {
              const int kpos = base + sub * 32 + (r & 3) + 8 * (r >> 2) + 4 * h - 512;
              const int dq = qs0 + j * 32 + r31 - kpos;
              if (dq > 128 || dq < -128) s[j][sub][r] = -1e30f;
            }
        SB0;
      }
#pragma unroll
      for (int j = 0; j < 2; ++j) {
        float mx = -1e30f;
#pragma unroll
        for (int sub = 0; sub < 2; ++sub)
#pragma unroll
          for (int r = 0; r < 16; ++r) mx = fmaxf(mx, s[j][sub][r]);
        mx = xhalf_max(mx);
        const float mnew = fmaxf(m[j], mx * SC);
        const float alpha = ex2(m[j] - mnew);
        m[j] = mnew;
        s[j][0] = s[j][0] * SC - mnew;
        s[j][1] = s[j][1] * SC - mnew;
        f32x16 ps;
#pragma unroll
        for (int r = 0; r < 16; ++r) {
          s[j][0][r] = ex2(s[j][0][r]);
          s[j][1][r] = ex2(s[j][1][r]);
        }
        ps = s[j][0] + s[j][1];
        float psum = ((ps[0] + ps[1]) + (ps[2] + ps[3])) + ((ps[4] + ps[5]) + (ps[6] + ps[7])) +
                     (((ps[8] + ps[9]) + (ps[10] + ps[11])) + ((ps[12] + ps[13]) + (ps[14] + ps[15])));
        l[j] = l[j] * alpha + psum;
        if (__any(alpha != 1.f)) {
          O[j][0] = O[j][0] * alpha;
          O[j][1] = O[j][1] * alpha;
        }
      }
#pragma unroll
      for (int sub = 0; sub < 2; ++sub)
#pragma unroll
        for (int st = 0; st < 2; ++st) {
          bf16x8 pfv[2];
#pragma unroll
          for (int j = 0; j < 2; ++j) {
            u32x4 pu;
            pu[0] = pack2(s[j][sub][8 * st + 0], s[j][sub][8 * st + 1]);
            pu[1] = pack2(s[j][sub][8 * st + 2], s[j][sub][8 * st + 3]);
            pu[2] = pack2(s[j][sub][8 * st + 4], s[j][sub][8 * st + 5]);
            pu[3] = pack2(s[j][sub][8 * st + 6], s[j][sub][8 * st + 7]);
            pfv[j] = __builtin_bit_cast(bf16x8, pu);
          }
#pragma unroll
          for (int et = 0; et < 2; ++et) {
            const char* vp = cv + (et * 32 + r31) * 136 + (sub * 32 + 16 * st + 4 * h) * 2;
            const uint2 vlo = *(const uint2*)vp;
            const uint2 vhi = *(const uint2*)(vp + 16);
            u32x4 vu; vu[0] = vlo.x; vu[1] = vlo.y; vu[2] = vhi.x; vu[3] = vhi.y;
            const bf16x8 vfv = __builtin_bit_cast(bf16x8, vu);
            O[0][et] = __builtin_amdgcn_mfma_f32_32x32x16_bf16(vfv, pfv[0], O[0][et], 0, 0, 0);
            O[1][et] = __builtin_amdgcn_mfma_f32_32x32x16_bf16(vfv, pfv[1], O[1][et], 0, 0, 0);
          }
        }
      if (ti + 1 < ntiles) {
        const int nb = buf ^ 1;
        ATT_SWRITE(nb)
      }
      __syncthreads();
    }
#pragma unroll
    for (int j = 0; j < 2; ++j) {
      float lt = xhalf_sum(l[j]);
      const float inv = 1.f / lt;
      u16* orow = p.ATT + (long)(qrow0 + j * 32 + r31) * 1024 + qcol;
#pragma unroll
      for (int et = 0; et < 2; ++et)
#pragma unroll
        for (int g = 0; g < 4; ++g) {
          uint2 pk;
          pk.x = pack2(O[j][et][4 * g] * inv, O[j][et][4 * g + 1] * inv);
          pk.y = pack2(O[j][et][4 * g + 2] * inv, O[j][et][4 * g + 3] * inv);
          *(uint2*)(orow + et * 32 + 8 * g + 4 * h) = pk;
        }
    }
  }
}

DI void gemm_simple_item(const Params& p, int mode, int layer, const u16* A, long lda, const u16* Bt, int K, int nct, int nrt,
                         int row0, int gc, int tile, int k0, int klen, int part, char* smem) {
  TLW
  int rt, ct;
  {
    const int ntiles = nrt * nct, nwhole = (ntiles / 256) * 256;
    int patch, j;
    if (tile < nwhole) { const int w = tile >> 8, r = tile & 255; patch = w * 8 + (r & 7); j = r >> 3; }
    else { const int r = tile - nwhole; patch = (nwhole >> 5) + (r >> 5); j = r & 31; }
    const int npc = nct >> 2, pr = patch / npc, pc = patch % npc;
    rt = pr * 8 + (j >> 2); ct = pc * 4 + (j & 3);
  }
  f32x16 acc[4][2];
  zero_acc(acc);
  OPQ_LANE
  gemm256(acc, A + (long)rt * 256 * lda + k0, lda, Bt + (long)ct * 256 * K + k0, K, klen, smem);
  int mi, b, pos0; bool smp; rowinfo(row0 + rt * 256, mi, b, pos0, smp); (void)b; (void)pos0;
  if (mode == 1) {
    char* ws = smem + wid * 16384;
#pragma unroll
    for (int tm = 0; tm < 4; ++tm)
#pragma unroll
      for (int r = 0; r < 16; ++r) {
        const int lr = tm * 32 + (r & 3) + 8 * (r >> 2) + 4 * (lane >> 5);
#pragma unroll
        for (int tn = 0; tn < 2; ++tn) {
          const float v = acc[tm][tn][r];
          const float rl = v > 0.f ? v : 0.f;
          *(u16*)(ws + lr * 128 + (tn * 32 + (lane & 31)) * 2) = f2bf(rl * rl);
        }
      }
    const unsigned gbase = (unsigned)(row0 + rt * 256 + wr * 128) * 4096 + ct * 256 + wc * 64;
#pragma unroll
    for (int i = 0; i < 16; ++i) {
      const int lr = i * 8 + (lane >> 3), ch = lane & 7;
      const uint4 v = *(const uint4*)(ws + lr * 128 + ch * 16);
      *(uint4*)(p.FF + gbase + (unsigned)lr * 4096 + ch * 8) = v;
    }
    __syncthreads();
    return;
  }
  const int c0 = ct * 256 + CCOL(0);
  const float* gp = p.mod + ((unsigned)layer * 9 + mi) * 6144 + gc * 1024 + c0;
  const float g0 = gp[0], g1 = gp[32];
  const float* xsrc = (mode == 0) ? (smp ? p.x_sample + (size_t)(row0 + rt * 256 - 4096) * 1024 : p.x_prompt + (size_t)(row0 + rt * 256) * 1024)
                                  : p.out + (size_t)(row0 + rt * 256) * 1024;
  float* xdst = p.out + (size_t)(row0 + rt * 256) * 1024;
  if (part > 0) {
    float* pd = p.PT + (size_t)(part - 1) * 4096 * 1024 + (size_t)(row0 + rt * 256 - 32768) * 1024;
#pragma unroll
    for (int tm = 0; tm < 4; ++tm) {
      SB0;
#pragma unroll
      for (int r = 0; r < 16; ++r) {
        const unsigned o = (unsigned)CROW(tm, r) * 1024 + c0;
        pd[o] = g0 * acc[tm][0][r];
        pd[o + 32] = g1 * acc[tm][1][r];
      }
    }
  } else {
    float xa[2][8], xb[2][8];
#pragma unroll
    for (int q = 0; q < 8; ++q) {
      const unsigned o = (unsigned)CROW(0, q) * 1024 + c0;
      xa[0][q] = xsrc[o]; xb[0][q] = xsrc[o + 32];
    }
#pragma unroll
    for (int sidx = 0; sidx < 8; ++sidx) {
      const int tm = sidx >> 1, r0 = (sidx & 1) * 8;
      SB0;
      if (sidx < 7) {
        const int tmn = (sidx + 1) >> 1, rn = ((sidx + 1) & 1) * 8;
#pragma unroll
        for (int q = 0; q < 8; ++q) {
          const unsigned o = (unsigned)CROW(tmn, rn + q) * 1024 + c0;
          xa[(sidx + 1) & 1][q] = xsrc[o]; xb[(sidx + 1) & 1][q] = xsrc[o + 32];
        }
      }
      SB0;
#pragma unroll
      for (int q = 0; q < 8; ++q) {
        const unsigned o = (unsigned)CROW(tm, r0 + q) * 1024 + c0;
        xdst[o] = xa[sidx & 1][q] + g0 * acc[tm][0][r0 + q];
        xdst[o + 32] = xb[sidx & 1][q] + g1 * acc[tm][1][r0 + q];
      }
    }
  }
}

DI void gemm_simple_phase(const Params& p, int mode, int layer, const u16* A, long lda, const u16* Bt, int K, int nct,
                          int row0, int nrt, int gc, int nfull, int nsplit, char* smem) {
  const int ntiles = nrt * nct;
  const int nitems = nfull + (ntiles - nfull) * nsplit;
  for (int it = blockIdx.x; it < nitems; it += gridDim.x) {
    if (it < nfull) gemm_simple_item(p, mode, layer, A, lda, Bt, K, nct, nrt, row0, gc, it, 0, K, 0, smem);
    else {
      const int j = it - nfull, tile = nfull + j / nsplit, part = j % nsplit, klen = K / nsplit;
      gemm_simple_item(p, mode, layer, A, lda, Bt, K, nct, nrt, row0, gc, tile, part * klen, klen, part, smem);
    }
  }
}

DI float lg2sig(float x) { return -log2f(1.f + __expf(-x)); }

DI void in1_item(const Params& p, int round, int it, char* smem) {
  TLW
  const int R0 = round * RROWS;
  {
    const int rt = it / 28, job = it % 28;
    const int tl0 = rt * 256;
    f32x16 acc[4][2];
    zero_acc(acc);
    OPQ_LANE
    const u16* Hh = p.H + (long)(R0 + tl0) * 1024;
    int mi, b, pos0; bool smp; rowinfo(R0 + tl0, mi, b, pos0, smp); (void)mi; (void)b;
    if (job < 8) {
      const bool isk = job >= 4;
      const int hd = job & 3;
      gemm256(acc, Hh, 1024, p.wt_in1 + (long)((isk ? 1024 : 0) + hd * 256) * 1024, 1024, 1024, smem);
      const int half = wc >> 1;
      const int f = (wc & 1) * 32 + (lane & 31);
      u16* dst = isk ? p.Kr : p.Qr;
      const float scl = isk ? 0.0625f : 1.f;
#pragma unroll
      for (int tm = 0; tm < 4; ++tm) {
        SB0;
        float2 csv[16];
#pragma unroll
        for (int r = 0; r < 16; ++r) {
          if ((r & 7) == 0 && smp) {
#pragma unroll
            for (int q = r; q < r + 8; ++q) {
              const int pos = pos0 + CROW(tm, q);
              csv[q] = p.tab1[(half ? (pos & 63) : (pos >> 6)) * 64 + f];
            }
            SB0;
          }
          const int tl = tl0 + CROW(tm, r);
          float x1 = acc[tm][0][r], x2 = acc[tm][1][r];
          float o1 = x1, o2 = x2;
          if (smp) {
            const float2 cs = csv[r];
            o1 = x1 * cs.x - x2 * cs.y; o2 = x1 * cs.y + x2 * cs.x;
          }
          u16* q = dst + (unsigned)tl * 1024 + hd * 256 + half * 128 + f;
          q[0] = f2bf(o1 * scl); q[64] = f2bf(o2 * scl);
        }
      }
    } else if (job < 12) {
      const int hd = job - 8;
      gemm256(acc, p.wt_in1 + (long)(1024 + hd * 256) * 1024, 1024, Hh, 1024, 1024, smem);
      const int half = wr;
      const float lf = lg2sig(p.dec_f[hd]), lb = lg2sig(p.dec_b[hd]);
#pragma unroll
      for (int tn = 0; tn < 2; ++tn) {
        const int tl = tl0 + CCOL(tn);
        const int pos = pos0 + CCOL(tn);
        const int comp = half ? (pos & 63) : (pos >> 6);
        const int pc = smp ? (pos & 511) : pos;
        const int Lc = smp ? 512 : 256;
        const float df = ex2((float)(Lc - 1 - pc) * lf) * 0.0625f;
        const float db = ex2((float)pc * lb) * 0.0625f;
#pragma unroll
        for (int fh = 0; fh < 2; ++fh) {
          float2 csv[16];
#pragma unroll
          for (int r = 0; r < 16; ++r) {
            if ((r & 7) == 0 && smp) {
#pragma unroll
              for (int q = r; q < r + 8; ++q) csv[q] = p.tab1[comp * 64 + fh * 32 + (q & 3) + 8 * (q >> 2) + 4 * (lane >> 5)];
              SB0;
            }
            const int f = fh * 32 + (r & 3) + 8 * (r >> 2) + 4 * (lane >> 5);
            float x1 = acc[2 * fh][tn][r], x2 = acc[2 * fh + 1][tn][r];
            float o1 = x1, o2 = x2;
            if (smp) {
              const float2 cs = csv[r];
              o1 = x1 * cs.x - x2 * cs.y; o2 = x1 * cs.y + x2 * cs.x;
            }
            const long rowd = (unsigned)(hd * 256 + half * 128 + f) * RROWS + tl;
            p.KTf[rowd] = f2bf(o1 * df); p.KTf[rowd + 64u * RROWS] = f2bf(o2 * df);
            p.KTb[rowd] = f2bf(o1 * db); p.KTb[rowd + 64u * RROWS] = f2bf(o2 * db);
          }
        }
      }
    } else if (job < 20) {
      const int vt = job - 12;
      gemm256(acc, p.wt_in1 + (long)(2048 + vt * 256) * 1024, 1024, Hh, 1024, 1024, smem);
#pragma unroll
      for (int tm = 0; tm < 4; ++tm) {
        SB0;
#pragma unroll
        for (int tn = 0; tn < 2; ++tn)
#pragma unroll
          for (int r = 0; r < 16; ++r) {
            const int n = vt * 256 + CROW(tm, r);
            p.VTr[(unsigned)n * RROWS + tl0 + CCOL(tn)] = f2bf(acc[tm][tn][r]);
          }
      }
    } else {
      const int gt = job - 20;
      gemm256(acc, Hh, 1024, p.wt_in1 + (long)(4096 + gt * 256) * 1024, 1024, 1024, smem);
#pragma unroll
      for (int tm = 0; tm < 4; ++tm) {
        SB0;
#pragma unroll
        for (int tn = 0; tn < 2; ++tn)
#pragma unroll
          for (int r = 0; r < 16; ++r) {
            const float v = acc[tm][tn][r];
            p.SG[(unsigned)(tl0 + CROW(tm, r)) * 2048 + gt * 256 + CCOL(tn)] = f2bf(v / (1.f + __expf(-v)));
          }
      }
    }
  }
}

DI void in1_out1_phase(const Params& p, int rin, int rout, char* smem) {
  const int n_out = rout >= 0 ? 192 : 0, n_in = rin < 3 ? 48 * 28 : 0;
  for (int it = blockIdx.x; it < n_out + n_in; it += gridDim.x) {
    if (it < n_out) gemm_simple_item(p, 2, 1, p.Ob, 2048, p.wt_out1, 2048, 4, 48, rout * RROWS, 2, it, 0, 2048, 0, smem);
    else in1_item(p, rin, it - n_out, smem);
  }
}

DI void kvatt_phase(const Params& p, int round, char* smem) {
  TLW
  const int nsamp = round == 0 ? 2 : 3, ls0 = round == 0 ? 1 : 0;
  const int nA = nsamp * 8 * 4 * 2 * 2;
  const int nB = nsamp * 8 * 4 * 4;
  const int nC = round == 0 ? 16 * 4 * 2 * 2 : 0;
  const int nD = round == 0 ? 16 * 4 : 0;
  for (int it = blockIdx.x; it < nA + nB + nC + nD; it += gridDim.x) {
    f32x16 acc[4][2];
    zero_acc(acc);
    OPQ_LANE
    if (it < nA) {
      int i = it; const int et = i & 1; i >>= 1; const int dir = i & 1; i >>= 1; const int hd = i & 3; i >>= 2; const int c = i & 7; const int ls = ls0 + (i >> 3);
      const int tl0 = ls * 4096 + c * 512;
      const u16* KT = dir ? p.KTb : p.KTf;
      gemm256(acc, p.VTr + (long)(hd * 512 + et * 256) * RROWS + tl0, RROWS, KT + (long)(hd * 256) * RROWS + tl0, RROWS, 512, smem);
      u16* dst = p.KV + ((long)((ls * 8 + c) * 4 + hd) * 2 + dir) * 131072;
#pragma unroll
      for (int tm = 0; tm < 4; ++tm) {
        SB0;
#pragma unroll
        for (int tn = 0; tn < 2; ++tn)
#pragma unroll
          for (int r = 0; r < 16; ++r)
            dst[(unsigned)(et * 256 + CROW(tm, r)) * 256 + CCOL(tn)] = f2bf(acc[tm][tn][r]);
      }
    } else if (it < nA + nB + nC) {
      int tl0, hd, ib, jb;
      if (it < nA + nB) {
        int i = it - nA; jb = (i & 1) * 256; i >>= 1; ib = (i & 1) * 256; i >>= 1; hd = i & 3; i >>= 2; const int c = i & 7; const int ls = ls0 + (i >> 3);
        tl0 = ls * 4096 + c * 512;
      } else {
        tl0 = 0; hd = 0; ib = 0; jb = 0;
      }
      if (it < nA + nB) {
        gemm256(acc, p.Qr + (long)(tl0 + ib) * 1024 + hd * 256, 1024, p.Kr + (long)(tl0 + jb) * 1024 + hd * 256, 1024, 256, smem);
        const float lf = lg2sig(p.dec_f[hd]), lb = lg2sig(p.dec_b[hd]);
#pragma unroll
        for (int tm = 0; tm < 4; ++tm) {
          SB0;
#pragma unroll
          for (int tn = 0; tn < 2; ++tn)
#pragma unroll
            for (int r = 0; r < 16; ++r) {
              const int pi = ib + CROW(tm, r), pj = jb + CCOL(tn);
              const int df = pi - pj;
              const float D = df > 0 ? ex2((float)df * lf) : (df < 0 ? ex2((float)(-df) * lb) : 2.f);
              p.ATTb[(unsigned)(tl0 + pi) * 2048 + hd * 512 + pj] = f2bf(acc[tm][tn][r] * D);
            }
        }
      } else {
        int i = it - nA - nB; const int et = i & 1; i >>= 1; const int dir = i & 1; i >>= 1; const int hd2 = i & 3; i >>= 2; const int b = i;
        const int tl1 = b * 256;
        const u16* KT = dir ? p.KTb : p.KTf;
        gemm256(acc, KT + (long)(hd2 * 256) * RROWS + tl1, RROWS, p.VTr + (long)(hd2 * 512 + et * 256) * RROWS + tl1, RROWS, 256, smem);
        float* dst = p.out + (dir ? O_RB : O_RF) + (long)(b * 4 + hd2) * 131072;
#pragma unroll
        for (int tm = 0; tm < 4; ++tm) {
          SB0;
#pragma unroll
          for (int tn = 0; tn < 2; ++tn)
#pragma unroll
            for (int r = 0; r < 16; ++r)
              dst[(unsigned)(CROW(tm, r)) * 512 + et * 256 + CCOL(tn)] = acc[tm][tn][r];
        }
      }
    } else {
      int i = it - nA - nB - nC; const int hd = i & 3; i >>= 2; const int b = i;
      const int tl0 = b * 256;
      gemm256(acc, p.Qr + (long)tl0 * 1024 + hd * 256, 1024, p.Kr + (long)tl0 * 1024 + hd * 256, 1024, 256, smem);
      const float lf = lg2sig(p.dec_f[hd]), lb = lg2sig(p.dec_b[hd]);
#pragma unroll
      for (int tm = 0; tm < 4; ++tm) {
        SB0;
#pragma unroll
        for (int tn = 0; tn < 2; ++tn)
#pragma unroll
          for (int r = 0; r < 16; ++r) {
            const int pi = CROW(tm, r), pj = CCOL(tn);
            const int df = pi - pj;
            const float D = df > 0 ? ex2((float)df * lf) : (df < 0 ? ex2((float)(-df) * lb) : 2.f);
            p.ATTb[(unsigned)(tl0 + pi) * 2048 + hd * 512 + pj] = f2bf(acc[tm][tn][r] * D);
          }
      }
    }
  }
}

DI void scan_phase(const Params& p, int round) {
  const int nsamp = round == 0 ? 2 : 3, ls0 = round == 0 ? 1 : 0;
  int gz_ = threadIdx.x; asm volatile("" : "+v"(gz_));
  const int gid = blockIdx.x * NTH + gz_, gsz = gridDim.x * NTH;
  for (int i = gid; i < RROWS * 4; i += gsz) p.rowss[i] = 0.f;
  const int total = nsamp * 4 * 2 * 65536;
  for (int i = gid; i < total; i += gsz) {
    const int idx2 = i & 65535; int j = i >> 16;
    const int dir = j & 1; j >>= 1; const int hd = j & 3; j >>= 2; const int ls = ls0 + j;
    const int e = idx2 >> 7, d = (idx2 & 127) * 2;
    const int sb = round * 3 + ls - 1;
    const float* st = (dir ? p.st_b : p.st_f) + ((size_t)(sb * 4 + hd) * 256 + d) * 512 + e;
    float S0 = st[0], S1 = st[512];
    const float lg = lg2sig(dir ? p.dec_b[hd] : p.dec_f[hd]);
    const float gL = ex2(512.f * lg);
    unsigned* base = (unsigned*)(p.KV + ((size_t)((ls * 8) * 4 + hd) * 2 + dir) * 131072) + idx2;
    unsigned kv[8];
#pragma unroll
    for (int c = 0; c < 8; ++c) kv[c] = base[(size_t)c * (4 * 2 * 131072 / 2)];
    if (dir == 0) {
#pragma unroll
      for (int c = 0; c < 8; ++c) {
        const float k0 = bf2f((u16)(kv[c] & 0xffff)), k1 = bf2f((u16)(kv[c] >> 16));
        kv[c] = pack2(S0, S1);
        S0 = gL * S0 + k0; S1 = gL * S1 + k1;
      }
    } else {
#pragma unroll
      for (int c = 7; c >= 0; --c) {
        const float k0 = bf2f((u16)(kv[c] & 0xffff)), k1 = bf2f((u16)(kv[c] >> 16));
        kv[c] = pack2(S0, S1);
        S0 = gL * S0 + k0; S1 = gL * S1 + k1;
      }
    }
#pragma unroll
    for (int c = 0; c < 8; ++c) base[(size_t)c * (4 * 2 * 131072 / 2)] = kv[c];
  }
}

DI void r3_phase(const Params& p, int round, char* smem) {
  TLW
  const int nsamp = round == 0 ? 2 : 3, ls0 = round == 0 ? 1 : 0;
  const int nA = nsamp * 8 * 4 * 4;
  const int nB = round == 0 ? 16 * 4 * 2 : 0;
  for (int it = blockIdx.x; it < nA + nB; it += gridDim.x) {
    f32x16 acc[4][2];
    zero_acc(acc);
    OPQ_LANE
    int tl0, hd, ib, et;
    if (it < nA) {
      int i = it; et = i & 1; i >>= 1; ib = (i & 1) * 256; i >>= 1; hd = i & 3; i >>= 2; const int c = i & 7; const int ls = ls0 + (i >> 3);
      tl0 = ls * 4096 + c * 512;
      const float lf = lg2sig(p.dec_f[hd]), lb = lg2sig(p.dec_b[hd]);
      const u16* Aq = p.Qr + (long)(tl0 + ib) * 1024 + hd * 256;
      const u16* Sf = p.KV + ((long)((ls * 8 + c) * 4 + hd) * 2 + 0) * 131072 + (long)et * 256 * 256;
      const u16* Sb = p.KV + ((long)((ls * 8 + c) * 4 + hd) * 2 + 1) * 131072 + (long)et * 256 * 256;
      gemm256(acc, Aq, 1024, Sf, 256, 256, smem);
      const float pbase = (float)(ib + wr * 128 + 4 * (lane >> 5));
      const float e1s = lf + lb, e1b = pbase * e1s + lf - 512.f * lb, e2b = (512.f - pbase) * lb;
#pragma unroll
      for (int tm = 0; tm < 4; ++tm) {
        SB0;
#pragma unroll
        for (int r = 0; r < 16; ++r) {
          const float sc = ex2(e1b + (float)(tm * 32 + (r & 3) + 8 * (r >> 2)) * e1s);
          acc[tm][0][r] *= sc; acc[tm][1][r] *= sc;
        }
      }
      gemm256(acc, Aq, 1024, Sb, 256, 256, smem);
#pragma unroll
      for (int tm = 0; tm < 4; ++tm) {
        SB0;
#pragma unroll
        for (int r = 0; r < 16; ++r) {
          const float sc = ex2(e2b - (float)(tm * 32 + (r & 3) + 8 * (r >> 2)) * lb);
          acc[tm][0][r] *= sc; acc[tm][1][r] *= sc;
        }
      }
      gemm256(acc, p.ATTb + (long)(tl0 + ib) * 2048 + hd * 512, 2048, p.VTr + (long)(hd * 512 + et * 256) * RROWS + tl0, RROWS, 512, smem);
    } else {
      int i = it - nA; et = i & 1; i >>= 1; hd = i & 3; i >>= 2; const int b = i;
      ib = 0;
      tl0 = b * 256;
      gemm256(acc, p.ATTb + (long)tl0 * 2048 + hd * 512, 2048, p.VTr + (long)(hd * 512 + et * 256) * RROWS + tl0, RROWS, 256, smem);
    }
#pragma unroll
    for (int tm = 0; tm < 4; ++tm) {
      SB0;
      float ssv = 0.f;
#pragma unroll
      for (int r = 0; r < 16; ++r) {
        const int tl = tl0 + ib + CROW(tm, r);
        const float a0 = acc[tm][0][r], a1 = acc[tm][1][r];
        const float sd = red32_dpp(a0 * a0 + a1 * a1);
        { const float lo_ = rl31(sd), hi_ = rl63(sd); ssv = (lane == r) ? lo_ : ssv; ssv = (lane == 16 + r) ? hi_ : ssv; }
        u16* o = p.Ob + (unsigned)tl * 2048 + hd * 512 + et * 256;
        o[CCOL(0)] = f2bf(a0); o[CCOL(1)] = f2bf(a1);
      }
      if (lane < 32) {
        const int rr = lane & 15, hh = lane >> 4;
        const int tl = tl0 + ib + wr * 128 + tm * 32 + (rr & 3) + 8 * (rr >> 2) + 4 * hh;
        atomicAdd(p.rowss + (unsigned)tl * 4 + hd, ssv);
      }
    }
  }
}

DI void gate_phase(const Params& p) {
  int gz_ = threadIdx.x; asm volatile("" : "+v"(gz_));
  const int gid = blockIdx.x * NTH + gz_, gsz = gridDim.x * NTH;
  for (int i0 = gid; i0 < RROWS * 512; i0 += 4 * gsz) {
    uint2 ov[4], gv[4]; float4 gn[4]; float rs[4];
#pragma unroll
    for (int u = 0; u < 4; ++u) {
      const int i = i0 + u * gsz;
      if (i < RROWS * 512) {
        const int tl = i >> 9, c4 = (i & 511) * 4;
        ov[u] = *(const uint2*)(p.Ob + (size_t)tl * 2048 + c4);
        gv[u] = *(const uint2*)(p.SG + (size_t)tl * 2048 + c4);
        gn[u] = *(const float4*)(p.gn + c4);
        rs[u] = p.rowss[(size_t)tl * 4 + (c4 >> 9)];
      }
    }
#pragma unroll
    for (int u = 0; u < 4; ++u) {
      const int i = i0 + u * gsz;
      if (i < RROWS * 512) {
        const int tl = i >> 9, c4 = (i & 511) * 4;
        const float rinv = rsqrtf(rs[u] * (1.f / 512.f) + EPSF);
        const float o0 = bf2f((u16)(ov[u].x & 0xffff)) * rinv * gn[u].x * bf2f((u16)(gv[u].x & 0xffff));
        const float o1 = bf2f((u16)(ov[u].x >> 16)) * rinv * gn[u].y * bf2f((u16)(gv[u].x >> 16));
        const float o2 = bf2f((u16)(ov[u].y & 0xffff)) * rinv * gn[u].z * bf2f((u16)(gv[u].y & 0xffff));
        const float o3 = bf2f((u16)(ov[u].y >> 16)) * rinv * gn[u].w * bf2f((u16)(gv[u].y >> 16));
        uint2 pk; pk.x = pack2(o0, o1); pk.y = pack2(o2, o3);
        *(uint2*)(p.Ob + (size_t)tl * 2048 + c4) = pk;
      }
    }
  }
}

DI void grid_bar(unsigned* ctr, unsigned epoch) {
  asm volatile("s_waitcnt vmcnt(0)" ::: "memory");
  __syncthreads();
  if (threadIdx.x == 0) {
    __builtin_amdgcn_fence(__ATOMIC_RELEASE, "agent");
    asm volatile("s_waitcnt vmcnt(0)" ::: "memory");
    const unsigned g = blockIdx.x & 7u;
    const unsigned gsize = (gridDim.x + 7u - g) >> 3;
    const unsigned old = __hip_atomic_fetch_add(ctr + 32 + g * 32, 1u, __ATOMIC_RELAXED, __HIP_MEMORY_SCOPE_AGENT);
    if (old + 1u == gsize * epoch) __hip_atomic_fetch_add(ctr, 1u, __ATOMIC_RELAXED, __HIP_MEMORY_SCOPE_AGENT);
    const unsigned ngroups = gridDim.x < 8u ? gridDim.x : 8u;
    while (__hip_atomic_load(ctr, __ATOMIC_RELAXED, __HIP_MEMORY_SCOPE_AGENT) < ngroups * epoch) __builtin_amdgcn_s_sleep(2);
    __builtin_amdgcn_fence(__ATOMIC_ACQUIRE, "agent");
    asm volatile("s_waitcnt vmcnt(0)" ::: "memory");
  }
  __syncthreads();
}

#if !MULTI_LAUNCH
__global__ void __launch_bounds__(512, 2) mega_kernel(Params p) {
  __shared__ __attribute__((aligned(1024))) char smem[131072];
  cg::grid_group grid = cg::this_grid();
  unsigned bar_n = 0;
#define GBAR { bar_n += 1; grid_bar(p.bar, bar_n); }
  prep_phase(p, smem); grid.sync();
  norm_phase(p, 0, 0, true); GBAR
  in0_phase(p, smem); GBAR
  attn_phase(p, smem); GBAR
  gemm_simple_phase(p, 0, 0, p.ATT, 1024, p.wt_out0, 1024, 4, 0, 144, 2, 576, 1, smem); GBAR
  norm_phase(p, 0, 1, false); GBAR
  gemm_simple_phase(p, 1, 0, p.H, 1024, p.wt_w1[0], 1024, 16, 0, 144, 0, 2304, 1, smem); GBAR
  gemm_simple_phase(p, 2, 0, p.FF, 4096, p.wt_w2[0], 4096, 4, 0, 144, 5, 512, 4, smem); GBAR
  norm_phase(p, 1, 0, false, true); GBAR
  in1_out1_phase(p, 0, -1, smem); GBAR
#define ROUND_PHASES(round)                          \
    kvatt_phase(p, round, smem); GBAR                \
    scan_phase(p, round); GBAR                       \
    r3_phase(p, round, smem); GBAR                   \
    gate_phase(p); GBAR                              \
    in1_out1_phase(p, (round) + 1, round, smem); GBAR
  ROUND_PHASES(0)
  ROUND_PHASES(1)
  ROUND_PHASES(2)
  norm_phase(p, 1, 1, false); GBAR
  gemm_simple_phase(p, 1, 1, p.H, 1024, p.wt_w1[1], 1024, 16, 0, 144, 0, 2304, 1, smem); GBAR
  gemm_simple_phase(p, 2, 1, p.FF, 4096, p.wt_w2[1], 4096, 4, 0, 144, 5, 512, 4, smem); GBAR
  norm_phase(p, 0, 2, false, true);
}
#endif

extern "C" void kernel_launch(void* const* d_in, const int* in_sizes, int n_in, void* d_out, int out_size, void* d_ws, size_t ws_size,
                              hipStream_t stream) {
  Params p{};
  const float* const* in = (const float* const*)d_in;
  p.x_prompt = in[0]; p.x_sample = in[1]; p.c = in[2]; p.ck_a = in[3]; p.cv_a = in[4]; p.ck_s = in[5]; p.cv_s = in[6];
  p.st_f = in[7]; p.st_b = in[8]; p.c_ctx = in[9];
  p.ada_w[0] = in[10]; p.ada_b[0] = in[11]; p.norm_mix[0] = in[12]; p.norm_mlp[0] = in[13];
  p.w_in0 = in[14]; p.q_norm = in[15]; p.k_norm = in[16]; p.sink = in[17]; p.w_out0 = in[18]; p.w1[0] = in[19]; p.w2[0] = in[20];
  p.ada_w[1] = in[21]; p.ada_b[1] = in[22]; p.norm_mix[1] = in[23]; p.norm_mlp[1] = in[24];
  p.w_in1 = in[25]; p.dec_f = in[26]; p.dec_b = in[27]; p.gn = in[28]; p.w_out1 = in[29]; p.w1[1] = in[30]; p.w2[1] = in[31];
  p.final_norm = in[32];
  p.out = (float*)d_out;
  char* w = (char*)d_ws;
  size_t off = 0;
  auto take = [&](size_t bytes) { char* r = w + off; off += (bytes + 255) & ~(size_t)255; return r; };
  p.wt_in0 = (u16*)take(1536UL * 1024 * 2);
  p.wt_out0 = (u16*)take(1024UL * 1024 * 2);
  p.wt_in1 = (u16*)take(6144UL * 1024 * 2);
  p.wt_out1 = (u16*)take(1024UL * 2048 * 2);
  for (int l = 0; l < 2; ++l) { p.wt_w1[l] = (u16*)take(4096UL * 1024 * 2); p.wt_w2[l] = (u16*)take(4096UL * 1024 * 2); }
  p.mod = (float*)take(2UL * 9 * 6144 * 4);
  p.tab0 = (float2*)take(1024UL * 8);
  p.tab1 = (float2*)take(4096UL * 8);
  p.rowss = (float*)take((size_t)RROWS * 4 * 4);
  p.bar = (unsigned*)take(2048);
  p.H = (u16*)take((size_t)NT * 1024 * 2);
  const size_t ubase = off;
  p.Q0 = (u16*)take((size_t)NT * 1024 * 2);
  p.ATT = (u16*)take((size_t)NT * 1024 * 2);
  for (int k = 0; k < 2; ++k) {
    p.KS[k] = (u16*)take(8UL * 2 * 4608 * 64 * 2);
    p.VTS[k] = (u16*)take(8UL * 2 * 4608 * 64 * 2);
    p.KP[k] = (u16*)take(16UL * 2 * 256 * 64 * 2);
    p.VTP[k] = (u16*)take(16UL * 2 * 256 * 64 * 2);
  }
  size_t end0 = off;
  off = ubase;
  p.FF = (u16*)take((size_t)NT * 4096 * 2);
  p.PT = (float*)take(3UL * 4096 * 1024 * 4);
  size_t end1 = off;
  off = ubase;
  p.Qr = (u16*)take((size_t)RROWS * 1024 * 2);
  p.Kr = (u16*)take((size_t)RROWS * 1024 * 2);
  p.KTf = (u16*)take((size_t)RROWS * 1024 * 2);
  p.KTb = (u16*)take((size_t)RROWS * 1024 * 2);
  p.VTr = (u16*)take((size_t)RROWS * 2048 * 2);
  p.SG = (u16*)take((size_t)RROWS * 2048 * 2);
  p.KV = (u16*)take(24UL * 4 * 2 * 131072 * 2);
  p.ATTb = (u16*)take((size_t)RROWS * 2048 * 2);
  p.Ob = (u16*)take((size_t)RROWS * 2048 * 2);
  size_t end2 = off;
  size_t need = end0 > end1 ? end0 : end1; if (end2 > need) need = end2;
  if (need > ws_size) { fprintf(stderr, "workspace too small: need %zu have %zu\n", need, ws_size); return; }

#if 0
#else
  static int grid_blocks = 0;
  if (!grid_blocks) {
    int dev = 0, cus = 0, per_cu = 0;
    hipGetDevice(&dev);
    hipDeviceGetAttribute(&cus, hipDeviceAttributeMultiprocessorCount, dev);
    hipOccupancyMaxActiveBlocksPerMultiprocessor(&per_cu, mega_kernel, 512, 0);
    if (per_cu > 1) per_cu = 1;
    grid_blocks = cus * per_cu;
  }
  hipMemsetAsync(p.bar, 0, 2048, stream);
  void* args[] = {&p};
  hipError_t e = hipLaunchCooperativeKernel((void*)mega_kernel, dim3(grid_blocks), dim3(512), args, 0, stream);
  if (e != hipSuccess) fprintf(stderr, "cooperative launch failed: %s (grid %d)\n", hipGetErrorString(e), grid_blocks);
#endif
}
```

```cpp
#include <hip/hip_runtime.h>
#include <hip/hip_cooperative_groups.h>
#include <cstdio>
namespace cg = cooperative_groups;

#ifndef MULTI_LAUNCH
#define MULTI_LAUNCH 0
#endif

typedef unsigned short u16;
typedef __attribute__((ext_vector_type(8))) short bf16x8;
typedef __attribute__((ext_vector_type(16))) float f32x16;
typedef __attribute__((ext_vector_type(4))) unsigned u32x4;

#define DI __device__ __forceinline__
#define NT 36864
#define RROWS 12288
#define EPSF 1e-6f
#define LOG2E 1.4426950408889634f

#define O_AK 37748736L
#define O_AV 38273024L
#define O_SK 38797312L
#define O_SV 39321600L
#define O_RF 39845888L
#define O_RB 48234496L

struct Params {
  const float *x_prompt, *x_sample, *c, *ck_a, *cv_a, *ck_s, *cv_s, *st_f, *st_b, *c_ctx;
  const float *ada_w[2], *ada_b[2], *norm_mix[2], *norm_mlp[2];
  const float *w_in0, *q_norm, *k_norm, *sink, *w_out0;
  const float *w_in1, *dec_f, *dec_b, *gn, *w_out1;
  const float *w1[2], *w2[2];
  const float *final_norm;
  float* out;
  u16 *wt_in0, *wt_out0, *wt_in1, *wt_out1, *wt_w1[2], *wt_w2[2];
  float* mod;
  float2* tab0;
  float2* tab1;
  float* rowss;
  unsigned* bar;
  u16* H;
  u16 *Q0, *ATT;
  u16 *KS[2], *VTS[2];
  u16 *KP[2], *VTP[2];
  u16* FF;
  float* PT;
  u16 *Qr, *Kr, *KTf, *KTb, *VTr, *SG, *KV, *ATTb, *Ob;
};

typedef __attribute__((ext_vector_type(2))) float f32x2_t;
typedef __attribute__((ext_vector_type(2))) __bf16 bf16x2_t;
DI unsigned pack2(float a, float b) { f32x2_t v; v.x = a; v.y = b; bf16x2_t r = __builtin_convertvector(v, bf16x2_t); return __builtin_bit_cast(unsigned, r); }
DI u16 f2bf(float f) { return (u16)(pack2(f, 0.f) & 0xffffu); }
DI float ex2(float x) { return __builtin_amdgcn_exp2f(x); }
#define SB0 __builtin_amdgcn_sched_barrier(0)
DI float bf2f(u16 h) { return __uint_as_float(((unsigned)h) << 16); }
#define NTH 512
#define LDS3 __attribute__((address_space(3)))

DI void rowinfo(int row, int& mi, int& b, int& pos, bool& smp) {
  if (row < 4096) { smp = false; b = row >> 8; pos = row & 255; mi = 0; }
  else { int s = row - 4096; smp = true; b = s >> 12; pos = s & 4095; mi = 1 + b; }
}

DI void zero_acc(f32x16 (&acc)[4][2]) {
#pragma unroll
  for (int a = 0; a < 4; ++a)
#pragma unroll
    for (int b = 0; b < 2; ++b)
#pragma unroll
      for (int r = 0; r < 16; ++r) acc[a][b][r] = 0.f;
}

DI void gemm256(f32x16 (&acc)[4][2], const u16* __restrict__ A, long lda, const u16* __restrict__ B, long ldb, int K, char* smem) {
  int tz_; asm volatile("v_mov_b32 %0, 0" : "=v"(tz_));
  const int t = threadIdx.x + tz_, lane = t & 63, wid = t >> 6, wr = wid >> 2, wc = wid & 3;
  const int lrow = t >> 3, gslot = (t & 7) ^ ((lrow >> 1) & 7);
  const unsigned voa = ((unsigned)lrow * (unsigned)lda + gslot * 8) * 2u;
  const unsigned vob = ((unsigned)lrow * (unsigned)ldb + gslot * 8) * 2u;
  const char* Ab = (const char*)A;
  const char* Bb = (const char*)B;
  char* sa = smem;
  char* sb = smem + 65536;
  const int nk = K >> 6;
#define G256_STAGE(buf_, kt_)                                                                                               \
  _Pragma("unroll") for (int i = 0; i < 4; ++i) {                                                                           \
    __builtin_amdgcn_global_load_lds((const unsigned*)(Ab + ((long)(64 * i) * lda + (kt_) * 64) * 2 + voa),                 \
                                     (LDS3 unsigned*)(sa + (buf_) * 32768 + i * 8192 + wid * 1024), 16, 0, 0);              \
    __builtin_amdgcn_global_load_lds((const unsigned*)(Bb + ((long)(64 * i) * ldb + (kt_) * 64) * 2 + vob),                 \
                                     (LDS3 unsigned*)(sb + (buf_) * 32768 + i * 8192 + wid * 1024), 16, 0, 0);              \
  }
  G256_STAGE(0, 0)
  asm volatile("s_waitcnt vmcnt(0)" ::: "memory");
  __syncthreads();
  const int r31 = lane & 31, h = lane >> 5, sw = (lane >> 1) & 7;
  const int aoff = (wr * 128 + r31) * 128;
  const int boff = (wc * 64 + r31) * 128;
  for (int kt = 0; kt < nk; ++kt) {
    const int buf = kt & 1;
    if (kt + 1 < nk) { G256_STAGE(buf ^ 1, kt + 1) }
    const char* ca = sa + buf * 32768 + aoff;
    const char* cb = sb + buf * 32768 + boff;
    bf16x8 af[2][4], bfr[2][2];
    {
      const int so = ((0 * 2 + h) ^ sw) << 4;
      bfr[0][0] = *(const bf16x8*)(cb + so);
      bfr[0][1] = *(const bf16x8*)(cb + 4096 + so);
#pragma unroll
      for (int tm = 0; tm < 4; ++tm) af[0][tm] = *(const bf16x8*)(ca + tm * 4096 + so);
    }
#pragma unroll
    for (int ks = 0; ks < 4; ++ks) {
      const int cur = ks & 1, nxt = cur ^ 1;
      if (ks < 3) {
        const int so = (((ks + 1) * 2 + h) ^ sw) << 4;
        bfr[nxt][0] = *(const bf16x8*)(cb + so);
        bfr[nxt][1] = *(const bf16x8*)(cb + 4096 + so);
#pragma unroll
        for (int tm = 0; tm < 4; ++tm) af[nxt][tm] = *(const bf16x8*)(ca + tm * 4096 + so);
      }
      SB0;
      __builtin_amdgcn_s_setprio(1);
#pragma unroll
      for (int tm = 0; tm < 4; ++tm) {
        acc[tm][0] = __builtin_amdgcn_mfma_f32_32x32x16_bf16(af[cur][tm], bfr[cur][0], acc[tm][0], 0, 0, 0);
        acc[tm][1] = __builtin_amdgcn_mfma_f32_32x32x16_bf16(af[cur][tm], bfr[cur][1], acc[tm][1], 0, 0, 0);
      }
      __builtin_amdgcn_s_setprio(0);
      SB0;
    }
    asm volatile("s_waitcnt vmcnt(0)" ::: "memory");
    __syncthreads();
  }
}

#define TLW const int t = threadIdx.x, wid = t >> 6, wr = wid >> 2, wc = wid & 3; (void)t; (void)wr; (void)wc;
#define OPQ_LANE int lane; { int z_; asm volatile("v_mov_b32 %0, 0" : "=v"(z_)); lane = (threadIdx.x + z_) & 63; } (void)lane;
#define CROW(tm, r) (wr * 128 + (tm) * 32 + ((r) & 3) + 8 * ((r) >> 2) + 4 * (lane >> 5))
#define CCOL(tn) (wc * 64 + (tn) * 32 + (lane & 31))

#define DPPF(x_, ctrl_, rmask_) __int_as_float(__builtin_amdgcn_update_dpp(0, __float_as_int(x_), ctrl_, rmask_, 0xf, false))
DI float red32_dpp(float x) {
  x += DPPF(x, 0xB1, 0xF);
  x += DPPF(x, 0x4E, 0xF);
  x += DPPF(x, 0x141, 0xF);
  x += DPPF(x, 0x140, 0xF);
  x += DPPF(x, 0x142, 0xA);
  return x;
}
DI float xhalf_max(float x) { auto r = __builtin_amdgcn_permlane32_swap(__float_as_uint(x), __float_as_uint(x), false, false); return fmaxf(__uint_as_float(r[0]), __uint_as_float(r[1])); }
DI float xhalf_sum(float x) { auto r = __builtin_amdgcn_permlane32_swap(__float_as_uint(x), __float_as_uint(x), false, false); return __uint_as_float(r[0]) + __uint_as_float(r[1]); }
DI float rl31(float x) { return __int_as_float(__builtin_amdgcn_readlane(__float_as_int(x), 31)); }
DI float rl63(float x) { return __int_as_float(__builtin_amdgcn_readlane(__float_as_int(x), 63)); }
DI float red32(float v) {
  v += __shfl_xor(v, 1); v += __shfl_xor(v, 2); v += __shfl_xor(v, 4); v += __shfl_xor(v, 8); v += __shfl_xor(v, 16);
  return v;
}

DI int perm_slot(int n, int perm) {
  if (perm == 1) {
    int hc = n >> 6, d = n & 63, nc; bool isv = false;
    if (hc < 8) nc = hc; else if (hc < 10) nc = 16 + (hc - 8); else if (hc < 12) { nc = 20 + (hc - 10); isv = true; }
    else if (hc < 20) nc = 8 + (hc - 12); else if (hc < 22) nc = 18 + (hc - 20); else { nc = 22 + (hc - 22); isv = true; }
    int half = d >> 5, x = (d >> 4) & 1, f = d & 15;
    return nc * 64 + (isv ? d : (x * 32 + half * 16 + f));
  } else if (perm == 2) {
    if (n >= 2048) return n;
    int d = n & 255, half = d >> 7, x = (d >> 6) & 1, f = d & 63;
    return (n & ~255) + half * 128 + (f >> 5) * 64 + x * 32 + (f & 31);
  }
  return n;
}

DI void transpose_weight(const float* __restrict__ W, int K, int N, u16* __restrict__ Wt, int perm, char* smem) {
  float* tile = (float*)smem;
  const int t = threadIdx.x;
  const int ntn = N >> 6;
  const int tiles = (K >> 6) * ntn;
  for (int it = blockIdx.x; it < tiles; it += 2 * gridDim.x) {
    const int it2 = it + gridDim.x;
    const bool has2 = it2 < tiles;
    const int nt0 = it % ntn, kt0 = it / ntn;
    const int nt1 = has2 ? it2 % ntn : nt0, kt1 = has2 ? it2 / ntn : kt0;
    float va[8], vb[8];
#pragma unroll
    for (int i = 0; i < 8; ++i) {
      const int r = (t >> 6) + 8 * i, cidx = t & 63;
      va[i] = W[(size_t)(kt0 * 64 + r) * N + nt0 * 64 + cidx];
      vb[i] = W[(size_t)(kt1 * 64 + r) * N + nt1 * 64 + cidx];
    }
#pragma unroll
    for (int i = 0; i < 8; ++i) {
      const int r = (t >> 6) + 8 * i, cidx = t & 63;
      tile[r * 65 + cidx] = va[i];
      tile[4160 + r * 65 + cidx] = vb[i];
    }
    __syncthreads();
#pragma unroll
    for (int i = 0; i < 4; ++i) {
      const int n = (t >> 5) + 16 * i, kp = t & 31;
      const unsigned v0 = pack2(tile[(2 * kp) * 65 + n], tile[(2 * kp + 1) * 65 + n]);
      const unsigned v1 = pack2(tile[4160 + (2 * kp) * 65 + n], tile[4160 + (2 * kp + 1) * 65 + n]);
      *(unsigned*)(Wt + (size_t)perm_slot(nt0 * 64 + n, perm) * K + kt0 * 64 + 2 * kp) = v0;
      if (has2) *(unsigned*)(Wt + (size_t)perm_slot(nt1 * 64 + n, perm) * K + kt1 * 64 + 2 * kp) = v1;
    }
    __syncthreads();
  }
}

DI void prep_phase(const Params& p, char* smem) {
  const int t = threadIdx.x;
  transpose_weight(p.w_in0, 1024, 1536, p.wt_in0, 1, smem);
  transpose_weight(p.w_out0, 1024, 1024, p.wt_out0, 0, smem);
  transpose_weight(p.w_in1, 1024, 6144, p.wt_in1, 2, smem);
  transpose_weight(p.w_out1, 2048, 1024, p.wt_out1, 0, smem);
  for (int l = 0; l < 2; ++l) {
    transpose_weight(p.w1[l], 1024, 4096, p.wt_w1[l], 0, smem);
    transpose_weight(p.w2[l], 4096, 1024, p.wt_w2[l], 0, smem);
  }
  {
    float* sc = (float*)smem;
    float* red = (float*)(smem + 36864);
    for (int it = blockIdx.x; it < 192; it += gridDim.x) {
      const int layer = it / 96, cb = it % 96;
      for (int i = t; i < 9216; i += NTH) {
        int r = i >> 10, k = i & 1023;
        float v = (r == 0) ? p.c_ctx[k] : p.c[(r - 1) * 1024 + k];
        sc[i] = v / (1.f + __expf(-v));
      }
      __syncthreads();
      const int n = cb * 64 + (t & 63), kg = t >> 6;
      float a[9];
#pragma unroll
      for (int r = 0; r < 9; ++r) a[r] = 0.f;
      const float* w = p.ada_w[layer] + (long)(kg * 128) * 6144 + n;
#pragma unroll 8
      for (int k = 0; k < 128; ++k) {
        float wv = w[(long)k * 6144];
#pragma unroll
        for (int r = 0; r < 9; ++r) a[r] += sc[r * 1024 + kg * 128 + k] * wv;
      }
#pragma unroll
      for (int r = 0; r < 9; ++r) red[(kg * 9 + r) * 64 + (t & 63)] = a[r];
      __syncthreads();
      for (int i = t; i < 576; i += NTH) {
        int r = i >> 6, cidx = i & 63;
        float s = 0.f;
#pragma unroll
        for (int g = 0; g < 8; ++g) s += red[(g * 9 + r) * 64 + cidx];
        int nn = cb * 64 + cidx;
        p.mod[((long)layer * 9 + r) * 6144 + nn] = s + p.ada_b[layer][nn];
      }
      __syncthreads();
    }
  }
  {
    int gz_ = t; asm volatile("" : "+v"(gz_));
    const int gid = blockIdx.x * NTH + gz_, gsz = gridDim.x * NTH;
    for (int i = gid; i < 2 * 524288; i += gsz) {
      int kind = (int)(i >> 19); int j = (int)(i & 524287);
      int d = j & 63, key = (j >> 6) & 511, kvh = (j >> 15) & 1, b = j >> 16;
      const float* ck = kind ? p.ck_s : p.ck_a;
      p.KS[kind][((long)(b * 2 + kvh) * 4608 + key) * 64 + d] = f2bf(ck[((long)(b * 512 + key) * 2 + kvh) * 64 + d]);
      int key2 = j & 511, e = (j >> 9) & 63;
      const float* cv = kind ? p.cv_s : p.cv_a;
      p.VTS[kind][((long)(b * 2 + kvh) * 64 + e) * 4608 + key2] = f2bf(cv[((long)(b * 512 + key2) * 2 + kvh) * 64 + e]);
    }
    for (int i = gid; i < 1024 + 4096; i += gsz) {
      int pos, f; double cbase;
      if (i < 1024) { pos = (int)(i >> 4); f = (int)(i & 15); cbase = 0.5623413251903491; }
      else { int j = (int)(i - 1024); pos = j >> 6; f = j & 63; cbase = 0.8659643233600653; }
      double inv = 1.0;
      for (int q = 0; q < f; ++q) inv *= cbase;
      double ang = (double)pos * inv;
      const double TWO_PI = 6.283185307179586476925;
      double n = rint(ang / TWO_PI);
      double rr = ang - n * TWO_PI;
      double r2 = rr * rr;
      double sn = 0.0, cs = 0.0, ts = rr, tc = 1.0;
      for (int q = 0; q < 14; ++q) {
        cs += tc; sn += ts;
        tc = -tc * r2 / (double)((2 * q + 1) * (2 * q + 2));
        ts = -ts * r2 / (double)((2 * q + 2) * (2 * q + 3));
      }
      float2 v; v.x = (float)cs; v.y = (float)sn;
      if (i < 1024) p.tab0[i] = v; else p.tab1[i - 1024] = v;
    }
  }
}

DI void norm_phase(const Params& p, int layer, int which, bool from_input, bool tailfix = false) {
  int tz_; asm volatile("v_mov_b32 %0, 0" : "=v"(tz_));
  const int tt_ = threadIdx.x + tz_;
  const int wave = tt_ >> 6, lane = tt_ & 63;
  for (int pidx = blockIdx.x * 8 + wave; pidx < NT / 2; pidx += gridDim.x * 8) {
    const int row = 2 * pidx;
    const float* x = from_input ? (row < 4096 ? p.x_prompt + (size_t)row * 1024 : p.x_sample + (size_t)(row - 4096) * 1024)
                                : p.out + (size_t)row * 1024;
    float4 va[4], vb[4], g[4], sc[4], sh[4];
#pragma unroll
    for (int i = 0; i < 4; ++i) {
      va[i] = ((const float4*)x)[lane + 64 * i];
      vb[i] = ((const float4*)(x + 1024))[lane + 64 * i];
    }
    if (tailfix && row >= 32768) {
#pragma unroll
      for (int q = 0; q < 3; ++q) {
        const float* pp = p.PT + (size_t)q * 4096 * 1024 + (size_t)(row - 32768) * 1024;
#pragma unroll
        for (int i = 0; i < 4; ++i) {
          const float4 a = ((const float4*)pp)[lane + 64 * i], b2 = ((const float4*)(pp + 1024))[lane + 64 * i];
          va[i].x += a.x; va[i].y += a.y; va[i].z += a.z; va[i].w += a.w;
          vb[i].x += b2.x; vb[i].y += b2.y; vb[i].z += b2.z; vb[i].w += b2.w;
        }
      }
      if (which != 2) {
#pragma unroll
        for (int i = 0; i < 4; ++i) {
          ((float4*)(p.out + (size_t)row * 1024))[lane + 64 * i] = va[i];
          ((float4*)(p.out + (size_t)(row + 1) * 1024))[lane + 64 * i] = vb[i];
        }
      }
    }
    if (which == 2) {
#pragma unroll
      for (int i = 0; i < 4; ++i) g[i] = ((const float4*)p.final_norm)[lane + 64 * i];
    } else {
      int mi, b, pos; bool smp; rowinfo(row, mi, b, pos, smp);
      const float* gain = which ? p.norm_mlp[layer] : p.norm_mix[layer];
      const float* mod = p.mod + ((size_t)layer * 9 + mi) * 6144;
      const float* shp = mod + (which ? 3 : 0) * 1024;
      const float* scp = mod + (which ? 4 : 1) * 1024;
#pragma unroll
      for (int i = 0; i < 4; ++i) {
        g[i] = ((const float4*)gain)[lane + 64 * i];
        sc[i] = ((const float4*)scp)[lane + 64 * i];
        sh[i] = ((const float4*)shp)[lane + 64 * i];
      }
    }
    SB0;
    float ssa = 0.f, ssb = 0.f;
#pragma unroll
    for (int i = 0; i < 4; ++i) {
      ssa += va[i].x * va[i].x + va[i].y * va[i].y + va[i].z * va[i].z + va[i].w * va[i].w;
      ssb += vb[i].x * vb[i].x + vb[i].y * vb[i].y + vb[i].z * vb[i].z + vb[i].w * vb[i].w;
    }
    { const float sd = red32_dpp(ssa); ssa = rl31(sd) + rl63(sd); }
    { const float sd = red32_dpp(ssb); ssb = rl31(sd) + rl63(sd); }
    const float ra = rsqrtf(ssa * (1.f / 1024.f) + EPSF), rb = rsqrtf(ssb * (1.f / 1024.f) + EPSF);
    if (which == 2) {
#pragma unroll
      for (int i = 0; i < 4; ++i) {
        float4 oa, ob;
        oa.x = va[i].x * ra * g[i].x; oa.y = va[i].y * ra * g[i].y; oa.z = va[i].z * ra * g[i].z; oa.w = va[i].w * ra * g[i].w;
        ob.x = vb[i].x * rb * g[i].x; ob.y = vb[i].y * rb * g[i].y; ob.z = vb[i].z * rb * g[i].z; ob.w = vb[i].w * rb * g[i].w;
        ((float4*)(p.out + (size_t)row * 1024))[lane + 64 * i] = oa;
        ((float4*)(p.out + (size_t)(row + 1) * 1024))[lane + 64 * i] = ob;
      }
    } else {
#pragma unroll
      for (int i = 0; i < 4; ++i) {
        const float m0 = g[i].x * (1.f + sc[i].x), m1 = g[i].y * (1.f + sc[i].y), m2 = g[i].z * (1.f + sc[i].z), m3 = g[i].w * (1.f + sc[i].w);
        uint2 pa, pb;
        pa.x = pack2(va[i].x * ra * m0 + sh[i].x, va[i].y * ra * m1 + sh[i].y);
        pa.y = pack2(va[i].z * ra * m2 + sh[i].z, va[i].w * ra * m3 + sh[i].w);
        pb.x = pack2(vb[i].x * rb * m0 + sh[i].x, vb[i].y * rb * m1 + sh[i].y);
        pb.y = pack2(vb[i].z * rb * m2 + sh[i].z, vb[i].w * rb * m3 + sh[i].w);
        *(uint2*)(p.H + (size_t)row * 1024 + (lane + 64 * i) * 4) = pa;
        *(uint2*)(p.H + (size_t)(row + 1) * 1024 + (lane + 64 * i) * 4) = pb;
      }
    }
  }
}

DI void in0_phase(const Params& p, char* smem) {
  TLW
  for (int it = blockIdx.x; it < 144 * 6; it += gridDim.x) {
    const int rt = it / 6, ct = it % 6;
    f32x16 acc[4][2];
    zero_acc(acc);
    OPQ_LANE
    int mi, b, pos0; bool smp; rowinfo(rt * 256, mi, b, pos0, smp); (void)mi;
    if (ct == 5) {
      gemm256(acc, p.wt_in0 + 1280L * 1024, 1024, p.H + (long)rt * 256 * 1024, 1024, 1024, smem);
      const int kind = wr;
      float* outv = p.out + (kind ? O_SV : O_AV);
#pragma unroll
      for (int tm = 0; tm < 4; ++tm) {
        SB0;
#pragma unroll
        for (int tn = 0; tn < 2; ++tn) {
          const int pos = pos0 + CCOL(tn);
          const int kvh = tm >> 1;
#pragma unroll
          for (int r = 0; r < 16; ++r) {
            const int e = (tm & 1) * 32 + (r & 3) + 8 * (r >> 2) + 4 * (lane >> 5);
            const float v = acc[tm][tn][r];
            if (smp) p.VTS[kind][((unsigned)(b * 2 + kvh) * 64 + e) * 4608 + 512 + pos] = f2bf(v);
            else {
              p.VTP[kind][((unsigned)(b * 2 + kvh) * 64 + e) * 256 + pos] = f2bf(v);
              outv[((unsigned)(b * 256 + pos) * 2 + kvh) * 64 + e] = v;
            }
          }
        }
      }
    } else {
      gemm256(acc, p.H + (long)rt * 256 * 1024, 1024, p.wt_in0 + (long)ct * 256 * 1024, 1024, 1024, smem);
      const int nc = ct * 4 + wc;
      const bool isq = nc < 16;
      const int kind = (nc >= 8 && nc < 16) || nc >= 18;
      const bool donorm = nc < 8 || nc == 16 || nc == 17;
      const float* gain = nc < 8 ? p.q_norm : p.k_norm;
      const int half = (lane >> 4) & 1, f = lane & 15;
      const int d0 = half * 32 + f, d1 = d0 + 16;
      float g0 = 1.f, g1 = 1.f;
      if (donorm) { g0 = gain[d0]; g1 = gain[d1]; }
      float* outk = p.out + (kind ? O_SK : O_AK);
#pragma unroll
      for (int tm = 0; tm < 4; ++tm) {
        SB0;
        float2 csv[16];
#pragma unroll
        for (int r = 0; r < 16; ++r) {
          if ((r & 7) == 0 && smp) {
#pragma unroll
            for (int q = r; q < r + 8; ++q) {
              const int pos = pos0 + CROW(tm, q);
              csv[q] = p.tab0[(half ? (pos & 63) : (pos >> 6)) * 16 + f];
            }
          }
          if ((r & 3) == 0) SB0;
          const int row = rt * 256 + CROW(tm, r);
          const int pos = pos0 + CROW(tm, r);
          float x1 = acc[tm][0][r], x2 = acc[tm][1][r];
          if (donorm) {
            const float sd = red32_dpp(x1 * x1 + x2 * x2);
            const float slo = rl31(sd), shi = rl63(sd);
            const float ss = (lane >> 5) ? shi : slo;
            float rinv = rsqrtf(ss * (1.f / 64.f) + EPSF);
            x1 *= rinv * g0; x2 *= rinv * g1;
          }
          float o1 = x1, o2 = x2;
          if (smp) {
            const float2 cs = csv[r];
            o1 = x1 * cs.x - x2 * cs.y; o2 = x1 * cs.y + x2 * cs.x;
          }
          if (isq) {
            const int qcol = kind * 512 + (nc & 7) * 64;
            u16* q = p.Q0 + (unsigned)row * 1024 + qcol;
            q[d0] = f2bf(o1); q[d1] = f2bf(o2);
          } else {
            const int kvh = nc & 1;
            if (smp) {
              u16* k = p.KS[kind] + ((unsigned)(b * 2 + kvh) * 4608 + 512 + pos) * 64;
              k[d0] = f2bf(o1); k[d1] = f2bf(o2);
            } else {
              u16* k = p.KP[kind] + ((unsigned)(b * 2 + kvh) * 256 + pos) * 64;
              k[d0] = f2bf(o1); k[d1] = f2bf(o2);
              float* ko = outk + ((unsigned)(b * 256 + pos) * 2 + kvh) * 64;
              ko[d0] = o1; ko[d1] = o2;
            }
          }
        }
      }
    }
  }
}

DI void attn_phase(const Params& p, char* smem) {
  const int t = threadIdx.x, lane = t & 63, wid = t >> 6;
  const int r31 = lane & 31, h = lane >> 5;
  char* sk = smem;
  char* sv = smem + 16384;
  const float SC = 0.125f * LOG2E;
  for (int it = blockIdx.x; it < 1152; it += gridDim.x) {
    int kind, b, kvh, q0, Lk; bool smp;
    if (it < 1024) { smp = true; kind = it >> 9; int i = it & 511; q0 = (i & 31) * 128; kvh = (i >> 5) & 1; b = i >> 6; Lk = 4608; }
    else { smp = false; int i = it - 1024; kind = i >> 6; i &= 63; q0 = (i & 1) * 128; kvh = (i >> 1) & 1; b = i >> 2; Lk = 256; }
    const u16* Kb = smp ? p.KS[kind] + (long)(b * 2 + kvh) * 4608 * 64 : p.KP[kind] + (long)(b * 2 + kvh) * 256 * 64;
    const u16* Vb = smp ? p.VTS[kind] + (long)(b * 2 + kvh) * 64 * 4608 : p.VTP[kind] + (long)(b * 2 + kvh) * 64 * 256;
    int n1, n2, lo;
    if (!smp) { n1 = 4; n2 = 0; lo = 0; }
    else if (kind == 0) { n1 = 72; n2 = 0; lo = 0; }
    else {
      n1 = 8;
      int kl = q0 - 128; if (kl < 0) kl = 0;
      int kh = q0 + 255; if (kh > 4095) kh = 4095;
      lo = (512 + kl) & ~63;
      n2 = ((512 + kh) - lo) / 64 + 1;
    }
    const int ntiles = n1 + n2;
    const int qs0 = q0 + (wid >> 2) * 64;
    const int qrow0 = smp ? 4096 + b * 4096 + qs0 : b * 256 + qs0;
    const int head = kvh * 4 + (wid & 3);
    const int qcol = kind * 512 + head * 64;
    bf16x8 qf[2][4];
#pragma unroll
    for (int j = 0; j < 2; ++j)
#pragma unroll
      for (int ks = 0; ks < 4; ++ks) qf[j][ks] = *(const bf16x8*)(p.Q0 + (long)(qrow0 + j * 32 + r31) * 1024 + qcol + ks * 16 + 8 * h);
    float m[2], l[2];
    f32x16 O[2][2];
#pragma unroll
    for (int j = 0; j < 2; ++j) {
      m[j] = kind ? p.sink[head] * LOG2E : -1e30f;
      l[j] = (kind && h == 0) ? 1.f : 0.f;
#pragma unroll
      for (int r = 0; r < 16; ++r) { O[j][0][r] = 0.f; O[j][1][r] = 0.f; }
    }
    uint4 rk0, rv0;
    const int key_l = t >> 3, slot_l = t & 7;
    const int kw0 = key_l * 128 + ((slot_l ^ ((key_l >> 1) & 7)) << 4);
    const int vw0 = key_l * 136 + slot_l * 16;
#define ATT_GLOAD(base_)                                                              \
    rk0 = *(const uint4*)(Kb + (long)((base_) + key_l) * 64 + slot_l * 8);            \
    rv0 = *(const uint4*)(Vb + (long)(key_l) * Lk + (base_) + slot_l * 8);
#define ATT_SWRITE(nb_)                                                               \
    *(uint4*)(sk + (nb_) * 8192 + kw0) = rk0;                                         \
    *(uint2*)(sv + (nb_) * 8704 + vw0) = make_uint2(rv0.x, rv0.y);                    \
    *(uint2*)(sv + (nb_) * 8704 + vw0 + 8) = make_uint2(rv0.z, rv0.w);
    ATT_GLOAD(0)
    ATT_SWRITE(0)
    __syncthreads();
    for (int ti = 0; ti < ntiles; ++ti) {
      const int buf = ti & 1;
      const int base = ti < n1 ? ti * 64 : lo + (ti - n1) * 64;
      const bool masked = ti >= n1;
      if (ti + 1 < ntiles) {
        const int nbase = (ti + 1) < n1 ? (ti + 1) * 64 : lo + (ti + 1 - n1) * 64;
        ATT_GLOAD(nbase)
      }
      const char* ck = sk + buf * 8192;
      const char* cv = sv + buf * 8704;
      f32x16 s[2][2];
#pragma unroll
      for (int j = 0; j < 2; ++j)
#pragma unroll
        for (int r = 0; r < 16; ++r) { s[j][0][r] = 0.f; s[j][1][r] = 0.f; }
#pragma unroll
      for (int sub = 0; sub < 2; ++sub)
#pragma unroll
        for (int ks = 0; ks < 4; ++ks) {
          bf16x8 kf = *(const bf16x8*)(ck + (sub * 32 + r31) * 128 + (((ks * 2 + h) ^ ((r31 >> 1) & 7)) << 4));
          s[0][sub] = __builtin_amdgcn_mfma_f32_32x32x16_bf16(kf, qf[0][ks], s[0][sub], 0, 0, 0);
          s[1][sub] = __builtin_amdgcn_mfma_f32_32x32x16_bf16(kf, qf[1][ks], s[1][sub], 0, 0, 0);
        }
      if (masked) {
#pragma unroll
        for (int j = 0; j < 2; ++j)
#pragma unroll
          for (int sub = 0; sub < 2; ++sub)
#pragma unroll
            for (int r = 0; r < 16; ++r) {
              const int kpos = base + sub * 32 + (r & 3) + 8 * (r >> 2) + 4 * h - 512;
              const int dq = qs0 + j * 32 + r31 - kpos;
              if (dq > 128 || dq < -128) s[j][sub][r] = -1e30f;
            }
        SB0;
      }
#pragma unroll
      for (int j = 0; j < 2; ++j) {
        float mx = -1e30f;
#pragma unroll
        for (int sub = 0; sub < 2; ++sub)
#pragma unroll
          for (int r = 0; r < 16; ++r) mx = fmaxf(mx, s[j][sub][r]);
        mx = xhalf_max(mx);
        const float mnew = fmaxf(m[j], mx * SC);
        const float alpha = ex2(m[j] - mnew);
        m[j] = mnew;
        s[j][0] = s[j][0] * SC - mnew;
        s[j][1] = s[j][1] * SC - mnew;
        f32x16 ps;
#pragma unroll
        for (int r = 0; r < 16; ++r) {
          s[j][0][r] = ex2(s[j][0][r]);
          s[j][1][r] = ex2(s[j][1][r]);
        }
        ps = s[j][0] + s[j][1];
        float psum = ((ps[0] + ps[1]) + (ps[2] + ps[3])) + ((ps[4] + ps[5]) + (ps[6] + ps[7])) +
                     (((ps[8] + ps[9]) + (ps[10] + ps[11])) + ((ps[12] + ps[13]) + (ps[14] + ps[15])));
        l[j] = l[j] * alpha + psum;
        if (__any(alpha != 1.f)) {
          O[j][0] = O[j][0] * alpha;
          O[j][1] = O[j][1] * alpha;
        }
      }
#pragma unroll
      for (int sub = 0; sub < 2; ++sub)
#pragma unroll
        for (int st = 0; st < 2; ++st) {
          bf16x8 pfv[2];
#pragma unroll
          for (int j = 0; j < 2; ++j) {
            u32x4 pu;
            pu[0] = pack2(s[j][sub][8 * st + 0], s[j][sub][8 * st + 1]);
            pu[1] = pack2(s[j][sub][8 * st + 2], s[j][sub][8 * st + 3]);
            pu[2] = pack2(s[j][sub][8 * st + 4], s[j][sub][8 * st + 5]);
            pu[3] = pack2(s[j][sub][8 * st + 6], s[j][sub][8 * st + 7]);
            pfv[j] = __builtin_bit_cast(bf16x8, pu);
          }
#pragma unroll
          for (int et = 0; et < 2; ++et) {
            const char* vp = cv + (et * 32 + r31) * 136 + (sub * 32 + 16 * st + 4 * h) * 2;
            const uint2 vlo = *(const uint2*)vp;
            const uint2 vhi = *(const uint2*)(vp + 16);
            u32x4 vu; vu[0] = vlo.x; vu[1] = vlo.y; vu[2] = vhi.x; vu[3] = vhi.y;
            const bf16x8 vfv = __builtin_bit_cast(bf16x8, vu);
            O[0][et] = __builtin_amdgcn_mfma_f32_32x32x16_bf16(vfv, pfv[0], O[0][et], 0, 0, 0);
            O[1][et] = __builtin_amdgcn_mfma_f32_32x32x16_bf16(vfv, pfv[1], O[1][et], 0, 0, 0);
          }
        }
      if (ti + 1 < ntiles) {
        const int nb = buf ^ 1;
        ATT_SWRITE(nb)
      }
      __syncthreads();
    }
#pragma unroll
    for (int j = 0; j < 2; ++j) {
      float lt = xhalf_sum(l[j]);
      const float inv = 1.f / lt;
      u16* orow = p.ATT + (long)(qrow0 + j * 32 + r31) * 1024 + qcol;
#pragma unroll
      for (int et = 0; et < 2; ++et)
#pragma unroll
        for (int g = 0; g < 4; ++g) {
          uint2 pk;
          pk.x = pack2(O[j][et][4 * g] * inv, O[j][et][4 * g + 1] * inv);
          pk.y = pack2(O[j][et][4 * g + 2] * inv, O[j][et][4 * g + 3] * inv);
          *(uint2*)(orow + et * 32 + 8 * g + 4 * h) = pk;
        }
    }
  }
}

DI void gemm_simple_item(const Params& p, int mode, int layer, const u16* A, long lda, const u16* Bt, int K, int nct, int nrt,
                         int row0, int gc, int tile, int k0, int klen, int part, char* smem) {
  TLW
  int rt, ct;
  {
    const int ntiles = nrt * nct, nwhole = (ntiles / 256) * 256;
    int patch, j;
    if (tile < nwhole) { const int w = tile >> 8, r = tile & 255; patch = w * 8 + (r & 7); j = r >> 3; }
    else { const int r = tile - nwhole; patch = (nwhole >> 5) + (r >> 5); j = r & 31; }
    const int npc = nct >> 2, pr = patch / npc, pc = patch % npc;
    rt = pr * 8 + (j >> 2); ct = pc * 4 + (j & 3);
  }
  f32x16 acc[4][2];
  zero_acc(acc);
  OPQ_LANE
  gemm256(acc, A + (long)rt * 256 * lda + k0, lda, Bt + (long)ct * 256 * K + k0, K, klen, smem);
  int mi, b, pos0; bool smp; rowinfo(row0 + rt * 256, mi, b, pos0, smp); (void)b; (void)pos0;
  if (mode == 1) {
    char* ws = smem + wid * 16384;
#pragma unroll
    for (int tm = 0; tm < 4; ++tm)
#pragma unroll
      for (int r = 0; r < 16; ++r) {
        const int lr = tm * 32 + (r & 3) + 8 * (r >> 2) + 4 * (lane >> 5);
#pragma unroll
        for (int tn = 0; tn < 2; ++tn) {
          const float v = acc[tm][tn][r];
          const float rl = v > 0.f ? v : 0.f;
          *(u16*)(ws + lr * 128 + (tn * 32 + (lane & 31)) * 2) = f2bf(rl * rl);
        }
      }
    const unsigned gbase = (unsigned)(row0 + rt * 256 + wr * 128) * 4096 + ct * 256 + wc * 64;
#pragma unroll
    for (int i = 0; i < 16; ++i) {
      const int lr = i * 8 + (lane >> 3), ch = lane & 7;
      const uint4 v = *(const uint4*)(ws + lr * 128 + ch * 16);
      *(uint4*)(p.FF + gbase + (unsigned)lr * 4096 + ch * 8) = v;
    }
    __syncthreads();
    return;
  }
  const int c0 = ct * 256 + CCOL(0);
  const float* gp = p.mod + ((unsigned)layer * 9 + mi) * 6144 + gc * 1024 + c0;
  const float g0 = gp[0], g1 = gp[32];
  const float* xsrc = (mode == 0) ? (smp ? p.x_sample + (size_t)(row0 + rt * 256 - 4096) * 1024 : p.x_prompt + (size_t)(row0 + rt * 256) * 1024)
                                  : p.out + (size_t)(row0 + rt * 256) * 1024;
  float* xdst = p.out + (size_t)(row0 + rt * 256) * 1024;
  if (part > 0) {
    float* pd = p.PT + (size_t)(part - 1) * 4096 * 1024 + (size_t)(row0 + rt * 256 - 32768) * 1024;
#pragma unroll
    for (int tm = 0; tm < 4; ++tm) {
      SB0;
#pragma unroll
      for (int r = 0; r < 16; ++r) {
        const unsigned o = (unsigned)CROW(tm, r) * 1024 + c0;
        pd[o] = g0 * acc[tm][0][r];
        pd[o + 32] = g1 * acc[tm][1][r];
      }
    }
  } else {
    float xa[2][8], xb[2][8];
#pragma unroll
    for (int q = 0; q < 8; ++q) {
      const unsigned o = (unsigned)CROW(0, q) * 1024 + c0;
      xa[0][q] = xsrc[o]; xb[0][q] = xsrc[o + 32];
    }
#pragma unroll
    for (int sidx = 0; sidx < 8; ++sidx) {
      const int tm = sidx >> 1, r0 = (sidx & 1) * 8;
      SB0;
      if (sidx < 7) {
        const int tmn = (sidx + 1) >> 1, rn = ((sidx + 1) & 1) * 8;
#pragma unroll
        for (int q = 0; q < 8; ++q) {
          const unsigned o = (unsigned)CROW(tmn, rn + q) * 1024 + c0;
          xa[(sidx + 1) & 1][q] = xsrc[o]; xb[(sidx + 1) & 1][q] = xsrc[o + 32];
        }
      }
      SB0;
#pragma unroll
      for (int q = 0; q < 8; ++q) {
        const unsigned o = (unsigned)CROW(tm, r0 + q) * 1024 + c0;
        xdst[o] = xa[sidx & 1][q] + g0 * acc[tm][0][r0 + q];
        xdst[o + 32] = xb[sidx & 1][q] + g1 * acc[tm][1][r0 + q];
      }
    }
  }
}

DI void gemm_simple_phase(const Params& p, int mode, int layer, const u16* A, long lda, const u16* Bt, int K, int nct,
                          int row0, int nrt, int gc, int nfull, int nsplit, char* smem) {
  const int ntiles = nrt * nct;
  const int nitems = nfull + (ntiles - nfull) * nsplit;
  for (int it = blockIdx.x; it < nitems; it += gridDim.x) {
    if (it < nfull) gemm_simple_item(p, mode, layer, A, lda, Bt, K, nct, nrt, row0, gc, it, 0, K, 0, smem);
    else {
      const int j = it - nfull, tile = nfull + j / nsplit, part = j % nsplit, klen = K / nsplit;
      gemm_simple_item(p, mode, layer, A, lda, Bt, K, nct, nrt, row0, gc, tile, part * klen, klen, part, smem);
    }
  }
}

DI float lg2sig(float x) { return -log2f(1.f + __expf(-x)); }

DI void in1_item(const Params& p, int round, int it, char* smem) {
  TLW
  const int R0 = round * RROWS;
  {
    const int rt = it / 28, job = it % 28;
    const int tl0 = rt * 256;
    f32x16 acc[4][2];
    zero_acc(acc);
    OPQ_LANE
    const u16* Hh = p.H + (long)(R0 + tl0) * 1024;
    int mi, b, pos0; bool smp; rowinfo(R0 + tl0, mi, b, pos0, smp); (void)mi; (void)b;
    if (job < 8) {
      const bool isk = job >= 4;
      const int hd = job & 3;
      gemm256(acc, Hh, 1024, p.wt_in1 + (long)((isk ? 1024 : 0) + hd * 256) * 1024, 1024, 1024, smem);
      const int half = wc >> 1;
      const int f = (wc & 1) * 32 + (lane & 31);
      u16* dst = isk ? p.Kr : p.Qr;
      const float scl = isk ? 0.0625f : 1.f;
#pragma unroll
      for (int tm = 0; tm < 4; ++tm) {
        SB0;
        float2 csv[16];
#pragma unroll
        for (int r = 0; r < 16; ++r) {
          if ((r & 7) == 0 && smp) {
#pragma unroll
            for (int q = r; q < r + 8; ++q) {
              const int pos = pos0 + CROW(tm, q);
              csv[q] = p.tab1[(half ? (pos & 63) : (pos >> 6)) * 64 + f];
            }
            SB0;
          }
          const int tl = tl0 + CROW(tm, r);
          float x1 = acc[tm][0][r], x2 = acc[tm][1][r];
          float o1 = x1, o2 = x2;
          if (smp) {
            const float2 cs = csv[r];
            o1 = x1 * cs.x - x2 * cs.y; o2 = x1 * cs.y + x2 * cs.x;
          }
          u16* q = dst + (unsigned)tl * 1024 + hd * 256 + half * 128 + f;
          q[0] = f2bf(o1 * scl); q[64] = f2bf(o2 * scl);
        }
      }
    } else if (job < 12) {
      const int hd = job - 8;
      gemm256(acc, p.wt_in1 + (long)(1024 + hd * 256) * 1024, 1024, Hh, 1024, 1024, smem);
      const int half = wr;
      const float lf = lg2sig(p.dec_f[hd]), lb = lg2sig(p.dec_b[hd]);
#pragma unroll
      for (int tn = 0; tn < 2; ++tn) {
        const int tl = tl0 + CCOL(tn);
        const int pos = pos0 + CCOL(tn);
        const int comp = half ? (pos & 63) : (pos >> 6);
        const int pc = smp ? (pos & 511) : pos;
        const int Lc = smp ? 512 : 256;
        const float df = ex2((float)(Lc - 1 - pc) * lf) * 0.0625f;
        const float db = ex2((float)pc * lb) * 0.0625f;
#pragma unroll
        for (int fh = 0; fh < 2; ++fh) {
          float2 csv[16];
#pragma unroll
          for (int r = 0; r < 16; ++r) {
            if ((r & 7) == 0 && smp) {
#pragma unroll
              for (int q = r; q < r + 8; ++q) csv[q] = p.tab1[comp * 64 + fh * 32 + (q & 3) + 8 * (q >> 2) + 4 * (lane >> 5)];
              SB0;
            }
            const int f = fh * 32 + (r & 3) + 8 * (r >> 2) + 4 * (lane >> 5);
            float x1 = acc[2 * fh][tn][r], x2 = acc[2 * fh + 1][tn][r];
            float o1 = x1, o2 = x2;
            if (smp) {
              const float2 cs = csv[r];
              o1 = x1 * cs.x - x2 * cs.y; o2 = x1 * cs.y + x2 * cs.x;
            }
            const long rowd = (unsigned)(hd * 256 + half * 128 + f) * RROWS + tl;
            p.KTf[rowd] = f2bf(o1 * df); p.KTf[rowd + 64u * RROWS] = f2bf(o2 * df);
            p.KTb[rowd] = f2bf(o1 * db); p.KTb[rowd + 64u * RROWS] = f2bf(o2 * db);
          }
        }
      }
    } else if (job < 20) {
      const int vt = job - 12;
      gemm256(acc, p.wt_in1 + (long)(2048 + vt * 256) * 1024, 1024, Hh, 1024, 1024, smem);
#pragma unroll
      for (int tm = 0; tm < 4; ++tm) {
        SB0;
#pragma unroll
        for (int tn = 0; tn < 2; ++tn)
#pragma unroll
          for (int r = 0; r < 16; ++r) {
            const int n = vt * 256 + CROW(tm, r);
            p.VTr[(unsigned)n * RROWS + tl0 + CCOL(tn)] = f2bf(acc[tm][tn][r]);
          }
      }
    } else {
      const int gt = job - 20;
      gemm256(acc, Hh, 1024, p.wt_in1 + (long)(4096 + gt * 256) * 1024, 1024, 1024, smem);
#pragma unroll
      for (int tm = 0; tm < 4; ++tm) {
        SB0;
#pragma unroll
        for (int tn = 0; tn < 2; ++tn)
#pragma unroll
          for (int r = 0; r < 16; ++r) {
            const float v = acc[tm][tn][r];
            p.SG[(unsigned)(tl0 + CROW(tm, r)) * 2048 + gt * 256 + CCOL(tn)] = f2bf(v / (1.f + __expf(-v)));
          }
      }
    }
  }
}

DI void in1_out1_phase(const Params& p, int rin, int rout, char* smem) {
  const int n_out = rout >= 0 ? 192 : 0, n_in = rin < 3 ? 48 * 28 : 0;
  for (int it = blockIdx.x; it < n_out + n_in; it += gridDim.x) {
    if (it < n_out) gemm_simple_item(p, 2, 1, p.Ob, 2048, p.wt_out1, 2048, 4, 48, rout * RROWS, 2, it, 0, 2048, 0, smem);
    else in1_item(p, rin, it - n_out, smem);
  }
}

DI void kvatt_phase(const Params& p, int round, char* smem) {
  TLW
  const int nsamp = round == 0 ? 2 : 3, ls0 = round == 0 ? 1 : 0;
  const int nA = nsamp * 8 * 4 * 2 * 2;
  const int nB = nsamp * 8 * 4 * 4;
  const int nC = round == 0 ? 16 * 4 * 2 * 2 : 0;
  const int nD = round == 0 ? 16 * 4 : 0;
  for (int it = blockIdx.x; it < nA + nB + nC + nD; it += gridDim.x) {
    f32x16 acc[4][2];
    zero_acc(acc);
    OPQ_LANE
    if (it < nA) {
      int i = it; const int et = i & 1; i >>= 1; const int dir = i & 1; i >>= 1; const int hd = i & 3; i >>= 2; const int c = i & 7; const int ls = ls0 + (i >> 3);
      const int tl0 = ls * 4096 + c * 512;
      const u16* KT = dir ? p.KTb : p.KTf;
      gemm256(acc, p.VTr + (long)(hd * 512 + et * 256) * RROWS + tl0, RROWS, KT + (long)(hd * 256) * RROWS + tl0, RROWS, 512, smem);
      u16* dst = p.KV + ((long)((ls * 8 + c) * 4 + hd) * 2 + dir) * 131072;
#pragma unroll
      for (int tm = 0; tm < 4; ++tm) {
        SB0;
#pragma unroll
        for (int tn = 0; tn < 2; ++tn)
#pragma unroll
          for (int r = 0; r < 16; ++r)
            dst[(unsigned)(et * 256 + CROW(tm, r)) * 256 + CCOL(tn)] = f2bf(acc[tm][tn][r]);
      }
    } else if (it < nA + nB + nC) {
      int tl0, hd, ib, jb;
      if (it < nA + nB) {
        int i = it - nA; jb = (i & 1) * 256; i >>= 1; ib = (i & 1) * 256; i >>= 1; hd = i & 3; i >>= 2; const int c = i & 7; const int ls = ls0 + (i >> 3);
        tl0 = ls * 4096 + c * 512;
      } else {
        tl0 = 0; hd = 0; ib = 0; jb = 0;
      }
      if (it < nA + nB) {
        gemm256(acc, p.Qr + (long)(tl0 + ib) * 1024 + hd * 256, 1024, p.Kr + (long)(tl0 + jb) * 1024 + hd * 256, 1024, 256, smem);
        const float lf = lg2sig(p.dec_f[hd]), lb = lg2sig(p.dec_b[hd]);
#pragma unroll
        for (int tm = 0; tm < 4; ++tm) {
          SB0;
#pragma unroll
          for (int tn = 0; tn < 2; ++tn)
#pragma unroll
            for (int r = 0; r < 16; ++r) {
              const int pi = ib + CROW(tm, r), pj = jb + CCOL(tn);
              const int df = pi - pj;
              const float De = ex2(df > 0 ? (float)df * lf : (float)(-df) * lb); const float D = df == 0 ? 2.f : De;
              p.ATTb[(unsigned)(tl0 + pi) * 2048 + hd * 512 + pj] = f2bf(acc[tm][tn][r] * D);
            }
        }
      } else {
        int i = it - nA - nB; const int et = i & 1; i >>= 1; const int dir = i & 1; i >>= 1; const int hd2 = i & 3; i >>= 2; const int b = i;
        const int tl1 = b * 256;
        const u16* KT = dir ? p.KTb : p.KTf;
        gemm256(acc, KT + (long)(hd2 * 256) * RROWS + tl1, RROWS, p.VTr + (long)(hd2 * 512 + et * 256) * RROWS + tl1, RROWS, 256, smem);
        float* dst = p.out + (dir ? O_RB : O_RF) + (long)(b * 4 + hd2) * 131072;
#pragma unroll
        for (int tm = 0; tm < 4; ++tm) {
          SB0;
#pragma unroll
          for (int tn = 0; tn < 2; ++tn)
#pragma unroll
            for (int r = 0; r < 16; ++r)
              dst[(unsigned)(CROW(tm, r)) * 512 + et * 256 + CCOL(tn)] = acc[tm][tn][r];
        }
      }
    } else {
      int i = it - nA - nB - nC; const int hd = i & 3; i >>= 2; const int b = i;
      const int tl0 = b * 256;
      gemm256(acc, p.Qr + (long)tl0 * 1024 + hd * 256, 1024, p.Kr + (long)tl0 * 1024 + hd * 256, 1024, 256, smem);
      const float lf = lg2sig(p.dec_f[hd]), lb = lg2sig(p.dec_b[hd]);
#pragma unroll
      for (int tm = 0; tm < 4; ++tm) {
        SB0;
#pragma unroll
        for (int tn = 0; tn < 2; ++tn)
#pragma unroll
          for (int r = 0; r < 16; ++r) {
            const int pi = CROW(tm, r), pj = CCOL(tn);
            const int df = pi - pj;
            const float De = ex2(df > 0 ? (float)df * lf : (float)(-df) * lb); const float D = df == 0 ? 2.f : De;
            p.ATTb[(unsigned)(tl0 + pi) * 2048 + hd * 512 + pj] = f2bf(acc[tm][tn][r] * D);
          }
      }
    }
  }
}

DI void scan_phase(const Params& p, int round) {
  const int nsamp = round == 0 ? 2 : 3, ls0 = round == 0 ? 1 : 0;
  int gz_ = threadIdx.x; asm volatile("" : "+v"(gz_));
  const int gid = blockIdx.x * NTH + gz_, gsz = gridDim.x * NTH;
  for (int i = gid; i < RROWS * 4; i += gsz) p.rowss[i] = 0.f;
  const int total = nsamp * 4 * 2 * 65536;
  for (int i = gid; i < total; i += gsz) {
    const int idx2 = i & 65535; int j = i >> 16;
    const int dir = j & 1; j >>= 1; const int hd = j & 3; j >>= 2; const int ls = ls0 + j;
    const int e = idx2 >> 7, d = (idx2 & 127) * 2;
    const int sb = round * 3 + ls - 1;
    const float* st = (dir ? p.st_b : p.st_f) + ((size_t)(sb * 4 + hd) * 256 + d) * 512 + e;
    float S0 = st[0], S1 = st[512];
    const float lg = lg2sig(dir ? p.dec_b[hd] : p.dec_f[hd]);
    const float gL = ex2(512.f * lg);
    unsigned* base = (unsigned*)(p.KV + ((size_t)((ls * 8) * 4 + hd) * 2 + dir) * 131072) + idx2;
    unsigned kv[8];
#pragma unroll
    for (int c = 0; c < 8; ++c) kv[c] = base[(size_t)c * (4 * 2 * 131072 / 2)];
    if (dir == 0) {
#pragma unroll
      for (int c = 0; c < 8; ++c) {
        const float k0 = bf2f((u16)(kv[c] & 0xffff)), k1 = bf2f((u16)(kv[c] >> 16));
        kv[c] = pack2(S0, S1);
        S0 = gL * S0 + k0; S1 = gL * S1 + k1;
      }
    } else {
#pragma unroll
      for (int c = 7; c >= 0; --c) {
        const float k0 = bf2f((u16)(kv[c] & 0xffff)), k1 = bf2f((u16)(kv[c] >> 16));
        kv[c] = pack2(S0, S1);
        S0 = gL * S0 + k0; S1 = gL * S1 + k1;
      }
    }
#pragma unroll
    for (int c = 0; c < 8; ++c) base[(size_t)c * (4 * 2 * 131072 / 2)] = kv[c];
  }
}

DI void r3_phase(const Params& p, int round, char* smem) {
  TLW
  const int nsamp = round == 0 ? 2 : 3, ls0 = round == 0 ? 1 : 0;
  const int nA = nsamp * 8 * 4 * 4;
  const int nB = round == 0 ? 16 * 4 * 2 : 0;
  for (int it = blockIdx.x; it < nA + nB; it += gridDim.x) {
    f32x16 acc[4][2];
    zero_acc(acc);
    OPQ_LANE
    int tl0, hd, ib, et;
    if (it < nA) {
      int i = it; et = i & 1; i >>= 1; ib = (i & 1) * 256; i >>= 1; hd = i & 3; i >>= 2; const int c = i & 7; const int ls = ls0 + (i >> 3);
      tl0 = ls * 4096 + c * 512;
      const float lf = lg2sig(p.dec_f[hd]), lb = lg2sig(p.dec_b[hd]);
      const u16* Aq = p.Qr + (long)(tl0 + ib) * 1024 + hd * 256;
      const u16* Sf = p.KV + ((long)((ls * 8 + c) * 4 + hd) * 2 + 0) * 131072 + (long)et * 256 * 256;
      const u16* Sb = p.KV + ((long)((ls * 8 + c) * 4 + hd) * 2 + 1) * 131072 + (long)et * 256 * 256;
      gemm256(acc, Aq, 1024, Sf, 256, 256, smem);
      const float pbase = (float)(ib + wr * 128 + 4 * (lane >> 5));
      const float e1s = lf + lb, e1b = pbase * e1s + lf - 512.f * lb, e2b = (512.f - pbase) * lb;
#pragma unroll
      for (int tm = 0; tm < 4; ++tm) {
        SB0;
#pragma unroll
        for (int r = 0; r < 16; ++r) {
          const float sc = ex2(e1b + (float)(tm * 32 + (r & 3) + 8 * (r >> 2)) * e1s);
          acc[tm][0][r] *= sc; acc[tm][1][r] *= sc;
        }
      }
      gemm256(acc, Aq, 1024, Sb, 256, 256, smem);
#pragma unroll
      for (int tm = 0; tm < 4; ++tm) {
        SB0;
#pragma unroll
        for (int r = 0; r < 16; ++r) {
          const float sc = ex2(e2b - (float)(tm * 32 + (r & 3) + 8 * (r >> 2)) * lb);
          acc[tm][0][r] *= sc; acc[tm][1][r] *= sc;
        }
      }
      gemm256(acc, p.ATTb + (long)(tl0 + ib) * 2048 + hd * 512, 2048, p.VTr + (long)(hd * 512 + et * 256) * RROWS + tl0, RROWS, 512, smem);
    } else {
      int i = it - nA; et = i & 1; i >>= 1; hd = i & 3; i >>= 2; const int b = i;
      ib = 0;
      tl0 = b * 256;
      gemm256(acc, p.ATTb + (long)tl0 * 2048 + hd * 512, 2048, p.VTr + (long)(hd * 512 + et * 256) * RROWS + tl0, RROWS, 256, smem);
    }
#pragma unroll
    for (int tm = 0; tm < 4; ++tm) {
      SB0;
      float ssv = 0.f;
#pragma unroll
      for (int r = 0; r < 16; ++r) {
        const int tl = tl0 + ib + CROW(tm, r);
        const float a0 = acc[tm][0][r], a1 = acc[tm][1][r];
        const float sd = red32_dpp(a0 * a0 + a1 * a1);
        { const float lo_ = rl31(sd), hi_ = rl63(sd); ssv = (lane == r) ? lo_ : ssv; ssv = (lane == 16 + r) ? hi_ : ssv; }
        u16* o = p.Ob + (unsigned)tl * 2048 + hd * 512 + et * 256;
        o[CCOL(0)] = f2bf(a0); o[CCOL(1)] = f2bf(a1);
      }
      if (lane < 32) {
        const int rr = lane & 15, hh = lane >> 4;
        const int tl = tl0 + ib + wr * 128 + tm * 32 + (rr & 3) + 8 * (rr >> 2) + 4 * hh;
        atomicAdd(p.rowss + (unsigned)tl * 4 + hd, ssv);
      }
    }
  }
}

DI void gate_phase(const Params& p) {
  int gz_ = threadIdx.x; asm volatile("" : "+v"(gz_));
  const int gid = blockIdx.x * NTH + gz_, gsz = gridDim.x * NTH;
  for (int i0 = gid; i0 < RROWS * 512; i0 += 4 * gsz) {
    uint2 ov[4], gv[4]; float4 gn[4]; float rs[4];
#pragma unroll
    for (int u = 0; u < 4; ++u) {
      const int i = i0 + u * gsz;
      if (i < RROWS * 512) {
        const int tl = i >> 9, c4 = (i & 511) * 4;
        ov[u] = *(const uint2*)(p.Ob + (size_t)tl * 2048 + c4);
        gv[u] = *(const uint2*)(p.SG + (size_t)tl * 2048 + c4);
        gn[u] = *(const float4*)(p.gn + c4);
        rs[u] = p.rowss[(size_t)tl * 4 + (c4 >> 9)];
      }
    }
#pragma unroll
    for (int u = 0; u < 4; ++u) {
      const int i = i0 + u * gsz;
      if (i < RROWS * 512) {
        const int tl = i >> 9, c4 = (i & 511) * 4;
        const float rinv = rsqrtf(rs[u] * (1.f / 512.f) + EPSF);
        const float o0 = bf2f((u16)(ov[u].x & 0xffff)) * rinv * gn[u].x * bf2f((u16)(gv[u].x & 0xffff));
        const float o1 = bf2f((u16)(ov[u].x >> 16)) * rinv * gn[u].y * bf2f((u16)(gv[u].x >> 16));
        const float o2 = bf2f((u16)(ov[u].y & 0xffff)) * rinv * gn[u].z * bf2f((u16)(gv[u].y & 0xffff));
        const float o3 = bf2f((u16)(ov[u].y >> 16)) * rinv * gn[u].w * bf2f((u16)(gv[u].y >> 16));
        uint2 pk; pk.x = pack2(o0, o1); pk.y = pack2(o2, o3);
        *(uint2*)(p.Ob + (size_t)tl * 2048 + c4) = pk;
      }
    }
  }
}

DI void grid_bar(unsigned* ctr, unsigned epoch) {
  asm volatile("s_waitcnt vmcnt(0)" ::: "memory");
  __syncthreads();
  if (threadIdx.x == 0) {
    __builtin_amdgcn_fence(__ATOMIC_RELEASE, "agent");
    asm volatile("s_waitcnt vmcnt(0)" ::: "memory");
    const unsigned g = blockIdx.x & 7u;
    const unsigned gsize = (gridDim.x + 7u - g) >> 3;
    const unsigned old = __hip_atomic_fetch_add(ctr + 32 + g * 32, 1u, __ATOMIC_RELAXED, __HIP_MEMORY_SCOPE_AGENT);
    if (old + 1u == gsize * epoch) __hip_atomic_fetch_add(ctr, 1u, __ATOMIC_RELAXED, __HIP_MEMORY_SCOPE_AGENT);
    const unsigned ngroups = gridDim.x < 8u ? gridDim.x : 8u;
    while (__hip_atomic_load(ctr, __ATOMIC_RELAXED, __HIP_MEMORY_SCOPE_AGENT) < ngroups * epoch) __builtin_amdgcn_s_sleep(2);
    __builtin_amdgcn_fence(__ATOMIC_ACQUIRE, "agent");
    asm volatile("s_waitcnt vmcnt(0)" ::: "memory");
  }
  __syncthreads();
}

#if !MULTI_LAUNCH
__global__ void __launch_bounds__(512, 2) mega_kernel(Params p) {
  __shared__ __attribute__((aligned(1024))) char smem[131072];
  cg::grid_group grid = cg::this_grid();
  unsigned bar_n = 0;
#define GBAR { bar_n += 1; grid_bar(p.bar, bar_n); }
  if (blockIdx.x == 0 && threadIdx.x < 512) __hip_atomic_store(p.bar + threadIdx.x, 0u, __ATOMIC_RELAXED, __HIP_MEMORY_SCOPE_AGENT);
  prep_phase(p, smem); grid.sync();
  norm_phase(p, 0, 0, true); GBAR
  in0_phase(p, smem); GBAR
  attn_phase(p, smem); GBAR
  gemm_simple_phase(p, 0, 0, p.ATT, 1024, p.wt_out0, 1024, 4, 0, 144, 2, 576, 1, smem); GBAR
  norm_phase(p, 0, 1, false); GBAR
  gemm_simple_phase(p, 1, 0, p.H, 1024, p.wt_w1[0], 1024, 16, 0, 144, 0, 2304, 1, smem); GBAR
  gemm_simple_phase(p, 2, 0, p.FF, 4096, p.wt_w2[0], 4096, 4, 0, 144, 5, 512, 4, smem); GBAR
  norm_phase(p, 1, 0, false, true); GBAR
  in1_out1_phase(p, 0, -1, smem); GBAR
#define ROUND_PHASES(round)                          \
    kvatt_phase(p, round, smem); GBAR                \
    scan_phase(p, round); GBAR                       \
    r3_phase(p, round, smem); GBAR                   \
    gate_phase(p); GBAR                              \
    in1_out1_phase(p, (round) + 1, round, smem); GBAR
  ROUND_PHASES(0)
  ROUND_PHASES(1)
  ROUND_PHASES(2)
  norm_phase(p, 1, 1, false); GBAR
  gemm_simple_phase(p, 1, 1, p.H, 1024, p.wt_w1[1], 1024, 16, 0, 144, 0, 2304, 1, smem); GBAR
  gemm_simple_phase(p, 2, 1, p.FF, 4096, p.wt_w2[1], 4096, 4, 0, 144, 5, 512, 4, smem); GBAR
  norm_phase(p, 0, 2, false, true);
}
#endif

extern "C" void kernel_launch(void* const* d_in, const int* in_sizes, int n_in, void* d_out, int out_size, void* d_ws, size_t ws_size,
                              hipStream_t stream) {
  Params p{};
  const float* const* in = (const float* const*)d_in;
  p.x_prompt = in[0]; p.x_sample = in[1]; p.c = in[2]; p.ck_a = in[3]; p.cv_a = in[4]; p.ck_s = in[5]; p.cv_s = in[6];
  p.st_f = in[7]; p.st_b = in[8]; p.c_ctx = in[9];
  p.ada_w[0] = in[10]; p.ada_b[0] = in[11]; p.norm_mix[0] = in[12]; p.norm_mlp[0] = in[13];
  p.w_in0 = in[14]; p.q_norm = in[15]; p.k_norm = in[16]; p.sink = in[17]; p.w_out0 = in[18]; p.w1[0] = in[19]; p.w2[0] = in[20];
  p.ada_w[1] = in[21]; p.ada_b[1] = in[22]; p.norm_mix[1] = in[23]; p.norm_mlp[1] = in[24];
  p.w_in1 = in[25]; p.dec_f = in[26]; p.dec_b = in[27]; p.gn = in[28]; p.w_out1 = in[29]; p.w1[1] = in[30]; p.w2[1] = in[31];
  p.final_norm = in[32];
  p.out = (float*)d_out;
  char* w = (char*)d_ws;
  size_t off = 0;
  auto take = [&](size_t bytes) { char* r = w + off; off += (bytes + 255) & ~(size_t)255; return r; };
  p.wt_in0 = (u16*)take(1536UL * 1024 * 2);
  p.wt_out0 = (u16*)take(1024UL * 1024 * 2);
  p.wt_in1 = (u16*)take(6144UL * 1024 * 2);
  p.wt_out1 = (u16*)take(1024UL * 2048 * 2);
  for (int l = 0; l < 2; ++l) { p.wt_w1[l] = (u16*)take(4096UL * 1024 * 2); p.wt_w2[l] = (u16*)take(4096UL * 1024 * 2); }
  p.mod = (float*)take(2UL * 9 * 6144 * 4);
  p.tab0 = (float2*)take(1024UL * 8);
  p.tab1 = (float2*)take(4096UL * 8);
  p.rowss = (float*)take((size_t)RROWS * 4 * 4);
  p.bar = (unsigned*)take(2048);
  p.H = (u16*)take((size_t)NT * 1024 * 2);
  const size_t ubase = off;
  p.Q0 = (u16*)take((size_t)NT * 1024 * 2);
  p.ATT = (u16*)take((size_t)NT * 1024 * 2);
  for (int k = 0; k < 2; ++k) {
    p.KS[k] = (u16*)take(8UL * 2 * 4608 * 64 * 2);
    p.VTS[k] = (u16*)take(8UL * 2 * 4608 * 64 * 2);
    p.KP[k] = (u16*)take(16UL * 2 * 256 * 64 * 2);
    p.VTP[k] = (u16*)take(16UL * 2 * 256 * 64 * 2);
  }
  size_t end0 = off;
  off = ubase;
  p.FF = (u16*)take((size_t)NT * 4096 * 2);
  p.PT = (float*)take(3UL * 4096 * 1024 * 4);
  size_t end1 = off;
  off = ubase;
  p.Qr = (u16*)take((size_t)RROWS * 1024 * 2);
  p.Kr = (u16*)take((size_t)RROWS * 1024 * 2);
  p.KTf = (u16*)take((size_t)RROWS * 1024 * 2);
  p.KTb = (u16*)take((size_t)RROWS * 1024 * 2);
  p.VTr = (u16*)take((size_t)RROWS * 2048 * 2);
  p.SG = (u16*)take((size_t)RROWS * 2048 * 2);
  p.KV = (u16*)take(24UL * 4 * 2 * 131072 * 2);
  p.ATTb = (u16*)take((size_t)RROWS * 2048 * 2);
  p.Ob = (u16*)take((size_t)RROWS * 2048 * 2);
  size_t end2 = off;
  size_t need = end0 > end1 ? end0 : end1; if (end2 > need) need = end2;
  if (need > ws_size) { fprintf(stderr, "workspace too small: need %zu have %zu\n", need, ws_size); return; }

#if 0
#else
  static int grid_blocks = 0;
  if (!grid_blocks) {
    int dev = 0, cus = 0, per_cu = 0;
    hipGetDevice(&dev);
    hipDeviceGetAttribute(&cus, hipDeviceAttributeMultiprocessorCount, dev);
    hipOccupancyMaxActiveBlocksPerMultiprocessor(&per_cu, mega_kernel, 512, 0);
    if (per_cu > 1) per_cu = 1;
    grid_blocks = cus * per_cu;
  }
  void* args[] = {&p};
  hipError_t e = hipLaunchCooperativeKernel((void*)mega_kernel, dim3(grid_blocks), dim3(512), args, 0, stream);
  if (e != hipSuccess) fprintf(stderr, "cooperative launch failed: %s (grid %d)\n", hipGetErrorString(e), grid_blocks);
#endif
}
```

```cpp
#include <hip/hip_runtime.h>
#include <hip/hip_cooperative_groups.h>
#include <cstdio>
namespace cg = cooperative_groups;

#ifndef MULTI_LAUNCH
#define MULTI_LAUNCH 0
#endif

typedef unsigned short u16;
typedef __attribute__((ext_vector_type(8))) short bf16x8;
typedef __attribute__((ext_vector_type(16))) float f32x16;
typedef __attribute__((ext_vector_type(4))) unsigned u32x4;

#define DI __device__ __forceinline__
#define NT 36864
#define RROWS 12288
#define EPSF 1e-6f
#define LOG2E 1.4426950408889634f

#define O_AK 37748736L
#define O_AV 38273024L
#define O_SK 38797312L
#define O_SV 39321600L
#define O_RF 39845888L
#define O_RB 48234496L

struct Params {
  const float *x_prompt, *x_sample, *c, *ck_a, *cv_a, *ck_s, *cv_s, *st_f, *st_b, *c_ctx;
  const float *ada_w[2], *ada_b[2], *norm_mix[2], *norm_mlp[2];
  const float *w_in0, *q_norm, *k_norm, *sink, *w_out0;
  const float *w_in1, *dec_f, *dec_b, *gn, *w_out1;
  const float *w1[2], *w2[2];
  const float *final_norm;
  float* out;
  u16 *wt_in0, *wt_out0, *wt_in1, *wt_out1, *wt_w1[2], *wt_w2[2];
  float* mod;
  float2* tab0;
  float2* tab1;
  float* rowss;
  unsigned* bar;
  u16* H;
  u16 *Q0, *ATT;
  u16 *KS[2], *VTS[2];
  u16 *KP[2], *VTP[2];
  u16* FF;
  float* PT;
  u16 *Qr, *Kr, *KTf, *KTb, *VTr, *SG, *KV, *ATTb, *Ob;
};

typedef __attribute__((ext_vector_type(2))) float f32x2_t;
typedef __attribute__((ext_vector_type(2))) __bf16 bf16x2_t;
DI unsigned pack2(float a, float b) { f32x2_t v; v.x = a; v.y = b; bf16x2_t r = __builtin_convertvector(v, bf16x2_t); return __builtin_bit_cast(unsigned, r); }
DI u16 f2bf(float f) { return (u16)(pack2(f, 0.f) & 0xffffu); }
DI float ex2(float x) { return __builtin_amdgcn_exp2f(x); }
#define SB0 __builtin_amdgcn_sched_barrier(0)
DI float bf2f(u16 h) { return __uint_as_float(((unsigned)h) << 16); }
#define NTH 512
#define LDS3 __attribute__((address_space(3)))

DI void rowinfo(int row, int& mi, int& b, int& pos, bool& smp) {
  if (row < 4096) { smp = false; b = row >> 8; pos = row & 255; mi = 0; }
  else { int s = row - 4096; smp = true; b = s >> 12; pos = s & 4095; mi = 1 + b; }
}

DI void zero_acc(f32x16 (&acc)[4][2]) {
#pragma unroll
  for (int a = 0; a < 4; ++a)
#pragma unroll
    for (int b = 0; b < 2; ++b)
#pragma unroll
      for (int r = 0; r < 16; ++r) acc[a][b][r] = 0.f;
}

DI void gemm256(f32x16 (&acc)[4][2], const u16* __restrict__ A, long lda, const u16* __restrict__ B, long ldb, int K, char* smem) {
  int tz_; asm volatile("v_mov_b32 %0, 0" : "=v"(tz_));
  const int t = threadIdx.x + tz_, lane = t & 63, wid = t >> 6, wr = wid >> 2, wc = wid & 3;
  const int lrow = t >> 3, gslot = (t & 7) ^ ((lrow >> 1) & 7);
  const unsigned voa = ((unsigned)lrow * (unsigned)lda + gslot * 8) * 2u;
  const unsigned vob = ((unsigned)lrow * (unsigned)ldb + gslot * 8) * 2u;
  const char* Ab = (const char*)A;
  const char* Bb = (const char*)B;
  char* sa = smem;
  char* sb = smem + 65536;
  const int nk = K >> 6;
#define G256_STAGE(buf_, kt_)                                                                                               \
  _Pragma("unroll") for (int i = 0; i < 4; ++i) {                                                                           \
    __builtin_amdgcn_global_load_lds((const unsigned*)(Ab + ((long)(64 * i) * lda + (kt_) * 64) * 2 + voa),                 \
                                     (LDS3 unsigned*)(sa + (buf_) * 32768 + i * 8192 + wid * 1024), 16, 0, 0);              \
    __builtin_amdgcn_global_load_lds((const unsigned*)(Bb + ((long)(64 * i) * ldb + (kt_) * 64) * 2 + vob),                 \
                                     (LDS3 unsigned*)(sb + (buf_) * 32768 + i * 8192 + wid * 1024), 16, 0, 0);              \
  }
  G256_STAGE(0, 0)
  asm volatile("s_waitcnt vmcnt(0)" ::: "memory");
  __syncthreads();
  const int r31 = lane & 31, h = lane >> 5, sw = (lane >> 1) & 7;
  const int aoff = (wr * 128 + r31) * 128;
  const int boff = (wc * 64 + r31) * 128;
  for (int kt = 0; kt < nk; ++kt) {
    const int buf = kt & 1;
    if (kt + 1 < nk) { G256_STAGE(buf ^ 1, kt + 1) }
    const char* ca = sa + buf * 32768 + aoff;
    const char* cb = sb + buf * 32768 + boff;
    bf16x8 af[2][4], bfr[2][2];
    {
      const int so = ((0 * 2 + h) ^ sw) << 4;
      bfr[0][0] = *(const bf16x8*)(cb + so);
      bfr[0][1] = *(const bf16x8*)(cb + 4096 + so);
#pragma unroll
      for (int tm = 0; tm < 4; ++tm) af[0][tm] = *(const bf16x8*)(ca + tm * 4096 + so);
    }
#pragma unroll
    for (int ks = 0; ks < 4; ++ks) {
      const int cur = ks & 1, nxt = cur ^ 1;
      if (ks < 3) {
        const int so = (((ks + 1) * 2 + h) ^ sw) << 4;
        bfr[nxt][0] = *(const bf16x8*)(cb + so);
        bfr[nxt][1] = *(const bf16x8*)(cb + 4096 + so);
#pragma unroll
        for (int tm = 0; tm < 4; ++tm) af[nxt][tm] = *(const bf16x8*)(ca + tm * 4096 + so);
      }
      SB0;
      __builtin_amdgcn_s_setprio(1);
#pragma unroll
      for (int tm = 0; tm < 4; ++tm) {
        acc[tm][0] = __builtin_amdgcn_mfma_f32_32x32x16_bf16(af[cur][tm], bfr[cur][0], acc[tm][0], 0, 0, 0);
        acc[tm][1] = __builtin_amdgcn_mfma_f32_32x32x16_bf16(af[cur][tm], bfr[cur][1], acc[tm][1], 0, 0, 0);
      }
      __builtin_amdgcn_s_setprio(0);
      SB0;
    }
    asm volatile("s_waitcnt vmcnt(0)" ::: "memory");
    __syncthreads();
  }
}

#define TLW const int t = threadIdx.x, wid = t >> 6, wr = wid >> 2, wc = wid & 3; (void)t; (void)wr; (void)wc;
#define OPQ_LANE int lane; { int z_; asm volatile("v_mov_b32 %0, 0" : "=v"(z_)); lane = (threadIdx.x + z_) & 63; } (void)lane;
#define CROW(tm, r) (wr * 128 + (tm) * 32 + ((r) & 3) + 8 * ((r) >> 2) + 4 * (lane >> 5))
#define CCOL(tn) (wc * 64 + (tn) * 32 + (lane & 31))

#define DPPF(x_, ctrl_, rmask_) __int_as_float(__builtin_amdgcn_update_dpp(0, __float_as_int(x_), ctrl_, rmask_, 0xf, false))
DI float red32_dpp(float x) {
  x += DPPF(x, 0xB1, 0xF);
  x += DPPF(x, 0x4E, 0xF);
  x += DPPF(x, 0x141, 0xF);
  x += DPPF(x, 0x140, 0xF);
  x += DPPF(x, 0x142, 0xA);
  return x;
}
DI float xhalf_max(float x) { auto r = __builtin_amdgcn_permlane32_swap(__float_as_uint(x), __float_as_uint(x), false, false); return fmaxf(__uint_as_float(r[0]), __uint_as_float(r[1])); }
DI float xhalf_sum(float x) { auto r = __builtin_amdgcn_permlane32_swap(__float_as_uint(x), __float_as_uint(x), false, false); return __uint_as_float(r[0]) + __uint_as_float(r[1]); }
DI float rl31(float x) { return __int_as_float(__builtin_amdgcn_readlane(__float_as_int(x), 31)); }
DI float rl63(float x) { return __int_as_float(__builtin_amdgcn_readlane(__float_as_int(x), 63)); }
DI float red32(float v) {
  v += __shfl_xor(v, 1); v += __shfl_xor(v, 2); v += __shfl_xor(v, 4); v += __shfl_xor(v, 8); v += __shfl_xor(v, 16);
  return v;
}

DI int perm_slot(int n, int perm) {
  if (perm == 1) {
    int hc = n >> 6, d = n & 63, nc; bool isv = false;
    if (hc < 8) nc = hc; else if (hc < 10) nc = 16 + (hc - 8); else if (hc < 12) { nc = 20 + (hc - 10); isv = true; }
    else if (hc < 20) nc = 8 + (hc - 12); else if (hc < 22) nc = 18 + (hc - 20); else { nc = 22 + (hc - 22); isv = true; }
    int half = d >> 5, x = (d >> 4) & 1, f = d & 15;
    return nc * 64 + (isv ? d : (x * 32 + half * 16 + f));
  } else if (perm == 2) {
    if (n >= 2048) return n;
    int d = n & 255, half = d >> 7, x = (d >> 6) & 1, f = d & 63;
    return (n & ~255) + half * 128 + (f >> 5) * 64 + x * 32 + (f & 31);
  }
  return n;
}

DI void transpose_weight(const float* __restrict__ W, int K, int N, u16* __restrict__ Wt, int perm, char* smem) {
  float* tile = (float*)smem;
  const int t = threadIdx.x;
  const int ntn = N >> 6;
  const int tiles = (K >> 6) * ntn;
  for (int it = blockIdx.x; it < tiles; it += 2 * gridDim.x) {
    const int it2 = it + gridDim.x;
    const bool has2 = it2 < tiles;
    const int nt0 = it % ntn, kt0 = it / ntn;
    const int nt1 = has2 ? it2 % ntn : nt0, kt1 = has2 ? it2 / ntn : kt0;
    float va[8], vb[8];
#pragma unroll
    for (int i = 0; i < 8; ++i) {
      const int r = (t >> 6) + 8 * i, cidx = t & 63;
      va[i] = W[(size_t)(kt0 * 64 + r) * N + nt0 * 64 + cidx];
      vb[i] = W[(size_t)(kt1 * 64 + r) * N + nt1 * 64 + cidx];
    }
#pragma unroll
    for (int i = 0; i < 8; ++i) {
      const int r = (t >> 6) + 8 * i, cidx = t & 63;
      tile[r * 65 + cidx] = va[i];
      tile[4160 + r * 65 + cidx] = vb[i];
    }
    __syncthreads();
#pragma unroll
    for (int i = 0; i < 4; ++i) {
      const int n = (t >> 5) + 16 * i, kp = t & 31;
      const unsigned v0 = pack2(tile[(2 * kp) * 65 + n], tile[(2 * kp + 1) * 65 + n]);
      const unsigned v1 = pack2(tile[4160 + (2 * kp) * 65 + n], tile[4160 + (2 * kp + 1) * 65 + n]);
      *(unsigned*)(Wt + (size_t)perm_slot(nt0 * 64 + n, perm) * K + kt0 * 64 + 2 * kp) = v0;
      if (has2) *(unsigned*)(Wt + (size_t)perm_slot(nt1 * 64 + n, perm) * K + kt1 * 64 + 2 * kp) = v1;
    }
    __syncthreads();
  }
}

DI void prep_phase(const Params& p, char* smem) {
  const int t = threadIdx.x;
  transpose_weight(p.w_in0, 1024, 1536, p.wt_in0, 1, smem);
  transpose_weight(p.w_out0, 1024, 1024, p.wt_out0, 0, smem);
  transpose_weight(p.w_in1, 1024, 6144, p.wt_in1, 2, smem);
  transpose_weight(p.w_out1, 2048, 1024, p.wt_out1, 0, smem);
  for (int l = 0; l < 2; ++l) {
    transpose_weight(p.w1[l], 1024, 4096, p.wt_w1[l], 0, smem);
    transpose_weight(p.w2[l], 4096, 1024, p.wt_w2[l], 0, smem);
  }
  {
    float* sc = (float*)smem;
    float* red = (float*)(smem + 36864);
    for (int it = blockIdx.x; it < 192; it += gridDim.x) {
      const int layer = it / 96, cb = it % 96;
      for (int i = t; i < 9216; i += NTH) {
        int r = i >> 10, k = i & 1023;
        float v = (r == 0) ? p.c_ctx[k] : p.c[(r - 1) * 1024 + k];
        sc[i] = v / (1.f + __expf(-v));
      }
      __syncthreads();
      const int n = cb * 64 + (t & 63), kg = t >> 6;
      float a[9];
#pragma unroll
      for (int r = 0; r < 9; ++r) a[r] = 0.f;
      const float* w = p.ada_w[layer] + (long)(kg * 128) * 6144 + n;
#pragma unroll 8
      for (int k = 0; k < 128; ++k) {
        float wv = w[(long)k * 6144];
#pragma unroll
        for (int r = 0; r < 9; ++r) a[r] += sc[r * 1024 + kg * 128 + k] * wv;
      }
#pragma unroll
      for (int r = 0; r < 9; ++r) red[(kg * 9 + r) * 64 + (t & 63)] = a[r];
      __syncthreads();
      for (int i = t; i < 576; i += NTH) {
        int r = i >> 6, cidx = i & 63;
        float s = 0.f;
#pragma unroll
        for (int g = 0; g < 8; ++g) s += red[(g * 9 + r) * 64 + cidx];
        int nn = cb * 64 + cidx;
        p.mod[((long)layer * 9 + r) * 6144 + nn] = s + p.ada_b[layer][nn];
      }
      __syncthreads();
    }
  }
  {
    int gz_ = t; asm volatile("" : "+v"(gz_));
    const int gid = blockIdx.x * NTH + gz_, gsz = gridDim.x * NTH;
    for (int i = gid; i < 2 * 524288; i += gsz) {
      int kind = (int)(i >> 19); int j = (int)(i & 524287);
      int d = j & 63, key = (j >> 6) & 511, kvh = (j >> 15) & 1, b = j >> 16;
      const float* ck = kind ? p.ck_s : p.ck_a;
      p.KS[kind][((long)(b * 2 + kvh) * 4608 + key) * 64 + d] = f2bf(ck[((long)(b * 512 + key) * 2 + kvh) * 64 + d]);
      int key2 = j & 511, e = (j >> 9) & 63;
      const float* cv = kind ? p.cv_s : p.cv_a;
      p.VTS[kind][((long)(b * 2 + kvh) * 64 + e) * 4608 + key2] = f2bf(cv[((long)(b * 512 + key2) * 2 + kvh) * 64 + e]);
    }
    for (int i = gid; i < 1024 + 4096; i += gsz) {
      int pos, f; double cbase;
      if (i < 1024) { pos = (int)(i >> 4); f = (int)(i & 15); cbase = 0.5623413251903491; }
      else { int j = (int)(i - 1024); pos = j >> 6; f = j & 63; cbase = 0.8659643233600653; }
      double inv = 1.0;
      for (int q = 0; q < f; ++q) inv *= cbase;
      double ang = (double)pos * inv;
      const double TWO_PI = 6.283185307179586476925;
      double n = rint(ang / TWO_PI);
      double rr = ang - n * TWO_PI;
      double r2 = rr * rr;
      double sn = 0.0, cs = 0.0, ts = rr, tc = 1.0;
      for (int q = 0; q < 14; ++q) {
        cs += tc; sn += ts;
        tc = -tc * r2 / (double)((2 * q + 1) * (2 * q + 2));
        ts = -ts * r2 / (double)((2 * q + 2) * (2 * q + 3));
      }
      float2 v; v.x = (float)cs; v.y = (float)sn;
      if (i < 1024) p.tab0[i] = v; else p.tab1[i - 1024] = v;
    }
  }
}

DI void norm_phase(const Params& p, int layer, int which, bool from_input, bool tailfix = false) {
  int tz_; asm volatile("v_mov_b32 %0, 0" : "=v"(tz_));
  const int tt_ = threadIdx.x + tz_;
  const int wave = tt_ >> 6, lane = tt_ & 63;
  for (int pidx = blockIdx.x * 8 + wave; pidx < NT / 2; pidx += gridDim.x * 8) {
    const int row = 2 * pidx;
    const float* x = from_input ? (row < 4096 ? p.x_prompt + (size_t)row * 1024 : p.x_sample + (size_t)(row - 4096) * 1024)
                                : p.out + (size_t)row * 1024;
    float4 va[4], vb[4], g[4], sc[4], sh[4];
#pragma unroll
    for (int i = 0; i < 4; ++i) {
      va[i] = ((const float4*)x)[lane + 64 * i];
      vb[i] = ((const float4*)(x + 1024))[lane + 64 * i];
    }
    if (tailfix && row >= 32768) {
#pragma unroll
      for (int q = 0; q < 3; ++q) {
        const float* pp = p.PT + (size_t)q * 4096 * 1024 + (size_t)(row - 32768) * 1024;
#pragma unroll
        for (int i = 0; i < 4; ++i) {
          const float4 a = ((const float4*)pp)[lane + 64 * i], b2 = ((const float4*)(pp + 1024))[lane + 64 * i];
          va[i].x += a.x; va[i].y += a.y; va[i].z += a.z; va[i].w += a.w;
          vb[i].x += b2.x; vb[i].y += b2.y; vb[i].z += b2.z; vb[i].w += b2.w;
        }
      }
      if (which != 2) {
#pragma unroll
        for (int i = 0; i < 4; ++i) {
          ((float4*)(p.out + (size_t)row * 1024))[lane + 64 * i] = va[i];
          ((float4*)(p.out + (size_t)(row + 1) * 1024))[lane + 64 * i] = vb[i];
        }
      }
    }
    if (which == 2) {
#pragma unroll
      for (int i = 0; i < 4; ++i) g[i] = ((const float4*)p.final_norm)[lane + 64 * i];
    } else {
      int mi, b, pos; bool smp; rowinfo(row, mi, b, pos, smp);
      const float* gain = which ? p.norm_mlp[layer] : p.norm_mix[layer];
      const float* mod = p.mod + ((size_t)layer * 9 + mi) * 6144;
      const float* shp = mod + (which ? 3 : 0) * 1024;
      const float* scp = mod + (which ? 4 : 1) * 1024;
#pragma unroll
      for (int i = 0; i < 4; ++i) {
        g[i] = ((const float4*)gain)[lane + 64 * i];
        sc[i] = ((const float4*)scp)[lane + 64 * i];
        sh[i] = ((const float4*)shp)[lane + 64 * i];
      }
    }
    SB0;
    float ssa = 0.f, ssb = 0.f;
#pragma unroll
    for (int i = 0; i < 4; ++i) {
      ssa += va[i].x * va[i].x + va[i].y * va[i].y + va[i].z * va[i].z + va[i].w * va[i].w;
      ssb += vb[i].x * vb[i].x + vb[i].y * vb[i].y + vb[i].z * vb[i].z + vb[i].w * vb[i].w;
    }
    { const float sd = red32_dpp(ssa); ssa = rl31(sd) + rl63(sd); }
    { const float sd = red32_dpp(ssb); ssb = rl31(sd) + rl63(sd); }
    const float ra = rsqrtf(ssa * (1.f / 1024.f) + EPSF), rb = rsqrtf(ssb * (1.f / 1024.f) + EPSF);
    if (which == 2) {
#pragma unroll
      for (int i = 0; i < 4; ++i) {
        float4 oa, ob;
        oa.x = va[i].x * ra * g[i].x; oa.y = va[i].y * ra * g[i].y; oa.z = va[i].z * ra * g[i].z; oa.w = va[i].w * ra * g[i].w;
        ob.x = vb[i].x * rb * g[i].x; ob.y = vb[i].y * rb * g[i].y; ob.z = vb[i].z * rb * g[i].z; ob.w = vb[i].w * rb * g[i].w;
        ((float4*)(p.out + (size_t)row * 1024))[lane + 64 * i] = oa;
        ((float4*)(p.out + (size_t)(row + 1) * 1024))[lane + 64 * i] = ob;
      }
    } else {
#pragma unroll
      for (int i = 0; i < 4; ++i) {
        const float m0 = g[i].x * (1.f + sc[i].x), m1 = g[i].y * (1.f + sc[i].y), m2 = g[i].z * (1.f + sc[i].z), m3 = g[i].w * (1.f + sc[i].w);
        uint2 pa, pb;
        pa.x = pack2(va[i].x * ra * m0 + sh[i].x, va[i].y * ra * m1 + sh[i].y);
        pa.y = pack2(va[i].z * ra * m2 + sh[i].z, va[i].w * ra * m3 + sh[i].w);
        pb.x = pack2(vb[i].x * rb * m0 + sh[i].x, vb[i].y * rb * m1 + sh[i].y);
        pb.y = pack2(vb[i].z * rb * m2 + sh[i].z, vb[i].w * rb * m3 + sh[i].w);
        *(uint2*)(p.H + (size_t)row * 1024 + (lane + 64 * i) * 4) = pa;
        *(uint2*)(p.H + (size_t)(row + 1) * 1024 + (lane + 64 * i) * 4) = pb;
      }
    }
  }
}

DI void in0_phase(const Params& p, char* smem) {
  TLW
  for (int it = blockIdx.x; it < 144 * 6; it += gridDim.x) {
    int rt, ct;
    {
      int patch, j;
      if (it < 768) { const int w = it >> 8, r = it & 255; patch = w * 8 + (r & 7); j = r >> 3; }
      else { const int r = it - 768; patch = 24 + (r >> 5); j = r & 31; }
      const int pr = patch / 3, pc = patch % 3;
      rt = pr * 16 + (j >> 1); ct = pc * 2 + (j & 1);
    }
    f32x16 acc[4][2];
    zero_acc(acc);
    OPQ_LANE
    int mi, b, pos0; bool smp; rowinfo(rt * 256, mi, b, pos0, smp); (void)mi;
    if (ct == 5) {
      gemm256(acc, p.wt_in0 + 1280L * 1024, 1024, p.H + (long)rt * 256 * 1024, 1024, 1024, smem);
      const int kind = wr;
      float* outv = p.out + (kind ? O_SV : O_AV);
#pragma unroll
      for (int tm = 0; tm < 4; ++tm) {
        SB0;
#pragma unroll
        for (int tn = 0; tn < 2; ++tn) {
          const int pos = pos0 + CCOL(tn);
          const int kvh = tm >> 1;
#pragma unroll
          for (int r = 0; r < 16; ++r) {
            const int e = (tm & 1) * 32 + (r & 3) + 8 * (r >> 2) + 4 * (lane >> 5);
            const float v = acc[tm][tn][r];
            if (smp) p.VTS[kind][((unsigned)(b * 2 + kvh) * 64 + e) * 4608 + 512 + pos] = f2bf(v);
            else {
              p.VTP[kind][((unsigned)(b * 2 + kvh) * 64 + e) * 256 + pos] = f2bf(v);
              outv[((unsigned)(b * 256 + pos) * 2 + kvh) * 64 + e] = v;
            }
          }
        }
      }
    } else {
      gemm256(acc, p.H + (long)rt * 256 * 1024, 1024, p.wt_in0 + (long)ct * 256 * 1024, 1024, 1024, smem);
      const int nc = ct * 4 + wc;
      const bool isq = nc < 16;
      const int kind = (nc >= 8 && nc < 16) || nc >= 18;
      const bool donorm = nc < 8 || nc == 16 || nc == 17;
      const float* gain = nc < 8 ? p.q_norm : p.k_norm;
      const int half = (lane >> 4) & 1, f = lane & 15;
      const int d0 = half * 32 + f, d1 = d0 + 16;
      float g0 = 1.f, g1 = 1.f;
      if (donorm) { g0 = gain[d0]; g1 = gain[d1]; }
      float* outk = p.out + (kind ? O_SK : O_AK);
#pragma unroll
      for (int tm = 0; tm < 4; ++tm) {
        SB0;
        float2 csv[16];
#pragma unroll
        for (int r = 0; r < 16; ++r) {
          if ((r & 7) == 0 && smp) {
#pragma unroll
            for (int q = r; q < r + 8; ++q) {
              const int pos = pos0 + CROW(tm, q);
              csv[q] = p.tab0[(half ? (pos & 63) : (pos >> 6)) * 16 + f];
            }
          }
          if ((r & 3) == 0) SB0;
          const int row = rt * 256 + CROW(tm, r);
          const int pos = pos0 + CROW(tm, r);
          float x1 = acc[tm][0][r], x2 = acc[tm][1][r];
          if (donorm) {
            const float sd = red32_dpp(x1 * x1 + x2 * x2);
            const float slo = rl31(sd), shi = rl63(sd);
            const float ss = (lane >> 5) ? shi : slo;
            float rinv = rsqrtf(ss * (1.f / 64.f) + EPSF);
            x1 *= rinv * g0; x2 *= rinv * g1;
          }
          float o1 = x1, o2 = x2;
          if (smp) {
            const float2 cs = csv[r];
            o1 = x1 * cs.x - x2 * cs.y; o2 = x1 * cs.y + x2 * cs.x;
          }
          if (isq) {
            const int qcol = kind * 512 + (nc & 7) * 64;
            u16* q = p.Q0 + (unsigned)row * 1024 + qcol;
            q[d0] = f2bf(o1); q[d1] = f2bf(o2);
          } else {
            const int kvh = nc & 1;
            if (smp) {
              u16* k = p.KS[kind] + ((unsigned)(b * 2 + kvh) * 4608 + 512 + pos) * 64;
              k[d0] = f2bf(o1); k[d1] = f2bf(o2);
            } else {
              u16* k = p.KP[kind] + ((unsigned)(b * 2 + kvh) * 256 + pos) * 64;
              k[d0] = f2bf(o1); k[d1] = f2bf(o2);
              float* ko = outk + ((unsigned)(b * 256 + pos) * 2 + kvh) * 64;
              ko[d0] = o1; ko[d1] = o2;
            }
          }
        }
      }
    }
  }
}

DI void attn_phase(const Params& p, char* smem) {
  const int t = threadIdx.x, lane = t & 63, wid = t >> 6;
  const int r31 = lane & 31, h = lane >> 5;
  char* sk = smem;
  char* sv = smem + 16384;
  const float SC = 0.125f * LOG2E;
  for (int it = blockIdx.x; it < 1152; it += gridDim.x) {
    int kind, b, kvh, q0, Lk; bool smp;
    if (it < 1024) { smp = true; kind = it >> 9; int i = it & 511; q0 = (i & 31) * 128; kvh = (i >> 5) & 1; b = i >> 6; Lk = 4608; }
    else { smp = false; int i = it - 1024; kind = i >> 6; i &= 63; q0 = (i & 1) * 128; kvh = (i >> 1) & 1; b = i >> 2; Lk = 256; }
    const u16* Kb = smp ? p.KS[kind] + (long)(b * 2 + kvh) * 4608 * 64 : p.KP[kind] + (long)(b * 2 + kvh) * 256 * 64;
    const u16* Vb = smp ? p.VTS[kind] + (long)(b * 2 + kvh) * 64 * 4608 : p.VTP[kind] + (long)(b * 2 + kvh) * 64 * 256;
    int n1, n2, lo;
    if (!smp) { n1 = 4; n2 = 0; lo = 0; }
    else if (kind == 0) { n1 = 72; n2 = 0; lo = 0; }
    else {
      n1 = 8;
      int kl = q0 - 128; if (kl < 0) kl = 0;
      int kh = q0 + 255; if (kh > 4095) kh = 4095;
      lo = (512 + kl) & ~63;
      n2 = ((512 + kh) - lo) / 64 + 1;
    }
    const int ntiles = n1 + n2;
    const int qs0 = q0 + (wid >> 2) * 64;
    const int qrow0 = smp ? 4096 + b * 4096 + qs0 : b * 256 + qs0;
    const int head = kvh * 4 + (wid & 3);
    const int qcol = kind * 512 + head * 64;
    bf16x8 qf[2][4];
#pragma unroll
    for (int j = 0; j < 2; ++j)
#pragma unroll
      for (int ks = 0; ks < 4; ++ks) qf[j][ks] = *(const bf16x8*)(p.Q0 + (long)(qrow0 + j * 32 + r31) * 1024 + qcol + ks * 16 + 8 * h);
    float m[2], l[2];
    f32x16 O[2][2];
#pragma unroll
    for (int j = 0; j < 2; ++j) {
      m[j] = kind ? p.sink[head] * LOG2E : -1e30f;
      l[j] = (kind && h == 0) ? 1.f : 0.f;
#pragma unroll
      for (int r = 0; r < 16; ++r) { O[j][0][r] = 0.f; O[j][1][r] = 0.f; }
    }
    uint4 rk0, rv0;
    const int key_l = t >> 3, slot_l = t & 7;
    const int kw0 = key_l * 128 + ((slot_l ^ ((key_l >> 1) & 7)) << 4);
    const int vw0 = key_l * 136 + slot_l * 16;
#define ATT_GLOAD(base_)                                                              \
    rk0 = *(const uint4*)(Kb + (long)((base_) + key_l) * 64 + slot_l * 8);            \
    rv0 = *(const uint4*)(Vb + (long)(key_l) * Lk + (base_) + slot_l * 8);
#define ATT_SWRITE(nb_)                                                               \
    *(uint4*)(sk + (nb_) * 8192 + kw0) = rk0;                                         \
    *(uint2*)(sv + (nb_) * 8704 + vw0) = make_uint2(rv0.x, rv0.y);                    \
    *(uint2*)(sv + (nb_) * 8704 + vw0 + 8) = make_uint2(rv0.z, rv0.w);
    ATT_GLOAD(0)
    ATT_SWRITE(0)
    __syncthreads();
    for (int ti = 0; ti < ntiles; ++ti) {
      const int buf = ti & 1;
      const int base = ti < n1 ? ti * 64 : lo + (ti - n1) * 64;
      const bool masked = ti >= n1;
      if (ti + 1 < ntiles) {
        const int nbase = (ti + 1) < n1 ? (ti + 1) * 64 : lo + (ti + 1 - n1) * 64;
        ATT_GLOAD(nbase)
      }
      const char* ck = sk + buf * 8192;
      const char* cv = sv + buf * 8704;
      f32x16 s[2][2];
#pragma unroll
      for (int j = 0; j < 2; ++j)
#pragma unroll
        for (int r = 0; r < 16; ++r) { s[j][0][r] = 0.f; s[j][1][r] = 0.f; }
#pragma unroll
      for (int sub = 0; sub < 2; ++sub)
#pragma unroll
        for (int ks = 0; ks < 4; ++ks) {
          bf16x8 kf = *(const bf16x8*)(ck + (sub * 32 + r31) * 128 + (((ks * 2 + h) ^ ((r31 >> 1) & 7)) << 4));
          s[0][sub] = __builtin_amdgcn_mfma_f32_32x32x16_bf16(kf, qf[0][ks], s[0][sub], 0, 0, 0);
          s[1][sub] = __builtin_amdgcn_mfma_f32_32x32x16_bf16(kf, qf[1][ks], s[1][sub], 0, 0, 0);
        }
      if (masked) {
#pragma unroll
        for (int j = 0; j < 2; ++j)
#pragma unroll
          for (int sub = 0; sub < 2; ++sub)
#pragma unroll
            for (int r = 0; r < 16; ++r) {
              const int kpos = base + sub * 32 + (r & 3) + 8 * (r >> 2) + 4 * h - 512;
              const int dq = qs0 + j * 32 + r31 - kpos;
              if (dq > 128 || dq < -128) s[j][sub][r] = -1e30f;
            }
        SB0;
      }
#pragma unroll
      for (int j = 0; j < 2; ++j) {
        float mx = -1e30f;
#pragma unroll
        for (int sub = 0; sub < 2; ++sub)
#pragma unroll
          for (int r = 0; r < 16; ++r) mx = fmaxf(mx, s[j][sub][r]);
        mx = xhalf_max(mx);
        const float mnew = fmaxf(m[j], mx * SC);
        const float alpha = ex2(m[j] - mnew);
        m[j] = mnew;
        s[j][0] = s[j][0] * SC - mnew;
        s[j][1] = s[j][1] * SC - mnew;
        f32x16 ps;
#pragma unroll
        for (int r = 0; r < 16; ++r) {
          s[j][0][r] = ex2(s[j][0][r]);
          s[j][1][r] = ex2(s[j][1][r]);
        }
        ps = s[j][0] + s[j][1];
        float psum = ((ps[0] + ps[1]) + (ps[2] + ps[3])) + ((ps[4] + ps[5]) + (ps[6] + ps[7])) +
                     (((ps[8] + ps[9]) + (ps[10] + ps[11])) + ((ps[12] + ps[13]) + (ps[14] + ps[15])));
        l[j] = l[j] * alpha + psum;
        if (__any(alpha != 1.f)) {
          O[j][0] = O[j][0] * alpha;
          O[j][1] = O[j][1] * alpha;
        }
      }
#pragma unroll
      for (int sub = 0; sub < 2; ++sub)
#pragma unroll
        for (int st = 0; st < 2; ++st) {
          bf16x8 pfv[2];
#pragma unroll
          for (int j = 0; j < 2; ++j) {
            u32x4 pu;
            pu[0] = pack2(s[j][sub][8 * st + 0], s[j][sub][8 * st + 1]);
            pu[1] = pack2(s[j][sub][8 * st + 2], s[j][sub][8 * st + 3]);
            pu[2] = pack2(s[j][sub][8 * st + 4], s[j][sub][8 * st + 5]);
            pu[3] = pack2(s[j][sub][8 * st + 6], s[j][sub][8 * st + 7]);
            pfv[j] = __builtin_bit_cast(bf16x8, pu);
          }
#pragma unroll
          for (int et = 0; et < 2; ++et) {
            const char* vp = cv + (et * 32 + r31) * 136 + (sub * 32 + 16 * st + 4 * h) * 2;
            const uint2 vlo = *(const uint2*)vp;
            const uint2 vhi = *(const uint2*)(vp + 16);
            u32x4 vu; vu[0] = vlo.x; vu[1] = vlo.y; vu[2] = vhi.x; vu[3] = vhi.y;
            const bf16x8 vfv = __builtin_bit_cast(bf16x8, vu);
            O[0][et] = __builtin_amdgcn_mfma_f32_32x32x16_bf16(vfv, pfv[0], O[0][et], 0, 0, 0);
            O[1][et] = __builtin_amdgcn_mfma_f32_32x32x16_bf16(vfv, pfv[1], O[1][et], 0, 0, 0);
          }
        }
      if (ti + 1 < ntiles) {
        const int nb = buf ^ 1;
        ATT_SWRITE(nb)
      }
      __syncthreads();
    }
#pragma unroll
    for (int j = 0; j < 2; ++j) {
      float lt = xhalf_sum(l[j]);
      const float inv = 1.f / lt;
      u16* orow = p.ATT + (long)(qrow0 + j * 32 + r31) * 1024 + qcol;
#pragma unroll
      for (int et = 0; et < 2; ++et)
#pragma unroll
        for (int g = 0; g < 4; ++g) {
          uint2 pk;
          pk.x = pack2(O[j][et][4 * g] * inv, O[j][et][4 * g + 1] * inv);
          pk.y = pack2(O[j][et][4 * g + 2] * inv, O[j][et][4 * g + 3] * inv);
          *(uint2*)(orow + et * 32 + 8 * g + 4 * h) = pk;
        }
    }
  }
}

DI void gemm_simple_item(const Params& p, int mode, int layer, const u16* A, long lda, const u16* Bt, int K, int nct, int nrt,
                         int row0, int gc, int tile, int k0, int klen, int part, char* smem) {
  TLW
  int rt, ct;
  {
    const int ntiles = nrt * nct, nwhole = (ntiles / 256) * 256;
    int patch, j;
    if (tile < nwhole) { const int w = tile >> 8, r = tile & 255; patch = w * 8 + (r & 7); j = r >> 3; }
    else { const int r = tile - nwhole; patch = (nwhole >> 5) + (r >> 5); j = r & 31; }
    const int npc = nct >> 2, pr = patch / npc, pc = patch % npc;
    rt = pr * 8 + (j >> 2); ct = pc * 4 + (j & 3);
  }
  f32x16 acc[4][2];
  zero_acc(acc);
  OPQ_LANE
  gemm256(acc, A + (long)rt * 256 * lda + k0, lda, Bt + (long)ct * 256 * K + k0, K, klen, smem);
  int mi, b, pos0; bool smp; rowinfo(row0 + rt * 256, mi, b, pos0, smp); (void)b; (void)pos0;
  if (mode == 1) {
    char* ws = smem + wid * 16384;
#pragma unroll
    for (int tm = 0; tm < 4; ++tm)
#pragma unroll
      for (int r = 0; r < 16; ++r) {
        const int lr = tm * 32 + (r & 3) + 8 * (r >> 2) + 4 * (lane >> 5);
#pragma unroll
        for (int tn = 0; tn < 2; ++tn) {
          const float v = acc[tm][tn][r];
          const float rl = v > 0.f ? v : 0.f;
          *(u16*)(ws + lr * 128 + (tn * 32 + (lane & 31)) * 2) = f2bf(rl * rl);
        }
      }
    const unsigned gbase = (unsigned)(row0 + rt * 256 + wr * 128) * 4096 + ct * 256 + wc * 64;
#pragma unroll
    for (int i = 0; i < 16; ++i) {
      const int lr = i * 8 + (lane >> 3), ch = lane & 7;
      const uint4 v = *(const uint4*)(ws + lr * 128 + ch * 16);
      *(uint4*)(p.FF + gbase + (unsigned)lr * 4096 + ch * 8) = v;
    }
    __syncthreads();
    return;
  }
  const int c0 = ct * 256 + CCOL(0);
  const float* gp = p.mod + ((unsigned)layer * 9 + mi) * 6144 + gc * 1024 + c0;
  const float g0 = gp[0], g1 = gp[32];
  const float* xsrc = (mode == 0) ? (smp ? p.x_sample + (size_t)(row0 + rt * 256 - 4096) * 1024 : p.x_prompt + (size_t)(row0 + rt * 256) * 1024)
                                  : p.out + (size_t)(row0 + rt * 256) * 1024;
  float* xdst = p.out + (size_t)(row0 + rt * 256) * 1024;
  if (part > 0) {
    float* pd = p.PT + (size_t)(part - 1) * 4096 * 1024 + (size_t)(row0 + rt * 256 - 32768) * 1024;
#pragma unroll
    for (int tm = 0; tm < 4; ++tm) {
      SB0;
#pragma unroll
      for (int r = 0; r < 16; ++r) {
        const unsigned o = (unsigned)CROW(tm, r) * 1024 + c0;
        pd[o] = g0 * acc[tm][0][r];
        pd[o + 32] = g1 * acc[tm][1][r];
      }
    }
  } else {
    float xa[2][8], xb[2][8];
#pragma unroll
    for (int q = 0; q < 8; ++q) {
      const unsigned o = (unsigned)CROW(0, q) * 1024 + c0;
      xa[0][q] = xsrc[o]; xb[0][q] = xsrc[o + 32];
    }
#pragma unroll
    for (int sidx = 0; sidx < 8; ++sidx) {
      const int tm = sidx >> 1, r0 = (sidx & 1) * 8;
      SB0;
      if (sidx < 7) {
        const int tmn = (sidx + 1) >> 1, rn = ((sidx + 1) & 1) * 8;
#pragma unroll
        for (int q = 0; q < 8; ++q) {
          const unsigned o = (unsigned)CROW(tmn, rn + q) * 1024 + c0;
          xa[(sidx + 1) & 1][q] = xsrc[o]; xb[(sidx + 1) & 1][q] = xsrc[o + 32];
        }
      }
      SB0;
#pragma unroll
      for (int q = 0; q < 8; ++q) {
        const unsigned o = (unsigned)CROW(tm, r0 + q) * 1024 + c0;
        xdst[o] = xa[sidx & 1][q] + g0 * acc[tm][0][r0 + q];
        xdst[o + 32] = xb[sidx & 1][q] + g1 * acc[tm][1][r0 + q];
      }
    }
  }
}

DI void gemm_simple_phase(const Params& p, int mode, int layer, const u16* A, long lda, const u16* Bt, int K, int nct,
                          int row0, int nrt, int gc, int nfull, int nsplit, char* smem) {
  const int ntiles = nrt * nct;
  const int nitems = nfull + (ntiles - nfull) * nsplit;
  for (int it = blockIdx.x; it < nitems; it += gridDim.x) {
    if (it < nfull) gemm_simple_item(p, mode, layer, A, lda, Bt, K, nct, nrt, row0, gc, it, 0, K, 0, smem);
    else {
      const int j = it - nfull, tile = nfull + j / nsplit, part = j % nsplit, klen = K / nsplit;
      gemm_simple_item(p, mode, layer, A, lda, Bt, K, nct, nrt, row0, gc, tile, part * klen, klen, part, smem);
    }
  }
}

DI float lg2sig(float x) { return -log2f(1.f + __expf(-x)); }

DI void in1_item(const Params& p, int round, int it, char* smem) {
  TLW
  const int R0 = round * RROWS;
  {
    const int rt = it / 28, job = it % 28;
    const int tl0 = rt * 256;
    f32x16 acc[4][2];
    zero_acc(acc);
    OPQ_LANE
    const u16* Hh = p.H + (long)(R0 + tl0) * 1024;
    int mi, b, pos0; bool smp; rowinfo(R0 + tl0, mi, b, pos0, smp); (void)mi; (void)b;
    if (job < 8) {
      const bool isk = job >= 4;
      const int hd = job & 3;
      gemm256(acc, Hh, 1024, p.wt_in1 + (long)((isk ? 1024 : 0) + hd * 256) * 1024, 1024, 1024, smem);
      const int half = wc >> 1;
      const int f = (wc & 1) * 32 + (lane & 31);
      u16* dst = isk ? p.Kr : p.Qr;
      const float scl = isk ? 0.0625f : 1.f;
#pragma unroll
      for (int tm = 0; tm < 4; ++tm) {
        SB0;
        float2 csv[16];
#pragma unroll
        for (int r = 0; r < 16; ++r) {
          if ((r & 7) == 0 && smp) {
#pragma unroll
            for (int q = r; q < r + 8; ++q) {
              const int pos = pos0 + CROW(tm, q);
              csv[q] = p.tab1[(half ? (pos & 63) : (pos >> 6)) * 64 + f];
            }
            SB0;
          }
          const int tl = tl0 + CROW(tm, r);
          float x1 = acc[tm][0][r], x2 = acc[tm][1][r];
          float o1 = x1, o2 = x2;
          if (smp) {
            const float2 cs = csv[r];
            o1 = x1 * cs.x - x2 * cs.y; o2 = x1 * cs.y + x2 * cs.x;
          }
          u16* q = dst + (unsigned)tl * 1024 + hd * 256 + half * 128 + f;
          q[0] = f2bf(o1 * scl); q[64] = f2bf(o2 * scl);
        }
      }
    } else if (job < 12) {
      const int hd = job - 8;
      gemm256(acc, p.wt_in1 + (long)(1024 + hd * 256) * 1024, 1024, Hh, 1024, 1024, smem);
      const int half = wr;
      const float lf = lg2sig(p.dec_f[hd]), lb = lg2sig(p.dec_b[hd]);
#pragma unroll
      for (int tn = 0; tn < 2; ++tn) {
        const int tl = tl0 + CCOL(tn);
        const int pos = pos0 + CCOL(tn);
        const int comp = half ? (pos & 63) : (pos >> 6);
        const int pc = smp ? (pos & 511) : pos;
        const int Lc = smp ? 512 : 256;
        const float df = ex2((float)(Lc - 1 - pc) * lf) * 0.0625f;
        const float db = ex2((float)pc * lb) * 0.0625f;
#pragma unroll
        for (int fh = 0; fh < 2; ++fh) {
          float2 csv[16];
#pragma unroll
          for (int r = 0; r < 16; ++r) {
            if ((r & 7) == 0 && smp) {
#pragma unroll
              for (int q = r; q < r + 8; ++q) csv[q] = p.tab1[comp * 64 + fh * 32 + (q & 3) + 8 * (q >> 2) + 4 * (lane >> 5)];
              SB0;
            }
            const int f = fh * 32 + (r & 3) + 8 * (r >> 2) + 4 * (lane >> 5);
            float x1 = acc[2 * fh][tn][r], x2 = acc[2 * fh + 1][tn][r];
            float o1 = x1, o2 = x2;
            if (smp) {
              const float2 cs = csv[r];
              o1 = x1 * cs.x - x2 * cs.y; o2 = x1 * cs.y + x2 * cs.x;
            }
            const long rowd = (unsigned)(hd * 256 + half * 128 + f) * RROWS + tl;
            p.KTf[rowd] = f2bf(o1 * df); p.KTf[rowd + 64u * RROWS] = f2bf(o2 * df);
            p.KTb[rowd] = f2bf(o1 * db); p.KTb[rowd + 64u * RROWS] = f2bf(o2 * db);
          }
        }
      }
    } else if (job < 20) {
      const int vt = job - 12;
      gemm256(acc, p.wt_in1 + (long)(2048 + vt * 256) * 1024, 1024, Hh, 1024, 1024, smem);
#pragma unroll
      for (int tm = 0; tm < 4; ++tm) {
        SB0;
#pragma unroll
        for (int tn = 0; tn < 2; ++tn)
#pragma unroll
          for (int r = 0; r < 16; ++r) {
            const int n = vt * 256 + CROW(tm, r);
            p.VTr[(unsigned)n * RROWS + tl0 + CCOL(tn)] = f2bf(acc[tm][tn][r]);
          }
      }
    } else {
      const int gt = job - 20;
      gemm256(acc, Hh, 1024, p.wt_in1 + (long)(4096 + gt * 256) * 1024, 1024, 1024, smem);
#pragma unroll
      for (int tm = 0; tm < 4; ++tm) {
        SB0;
#pragma unroll
        for (int tn = 0; tn < 2; ++tn)
#pragma unroll
          for (int r = 0; r < 16; ++r) {
            const float v = acc[tm][tn][r];
            p.SG[(unsigned)(tl0 + CROW(tm, r)) * 2048 + gt * 256 + CCOL(tn)] = f2bf(v / (1.f + __expf(-v)));
          }
      }
    }
  }
}

DI void in1_out1_phase(const Params& p, int rin, int rout, char* smem) {
  const int n_out = rout >= 0 ? 192 : 0, n_in = rin < 3 ? 48 * 28 : 0;
  for (int it = blockIdx.x; it < n_out + n_in; it += gridDim.x) {
    if (it < n_out) gemm_simple_item(p, 2, 1, p.Ob, 2048, p.wt_out1, 2048, 4, 48, rout * RROWS, 2, it, 0, 2048, 0, smem);
    else in1_item(p, rin, it - n_out, smem);
  }
}

DI void kvatt_phase(const Params& p, int round, char* smem) {
  TLW
  const int nsamp = round == 0 ? 2 : 3, ls0 = round == 0 ? 1 : 0;
  const int nA = nsamp * 8 * 4 * 2 * 2;
  const int nB = nsamp * 8 * 4 * 4;
  const int nC = round == 0 ? 16 * 4 * 2 * 2 : 0;
  const int nD = round == 0 ? 16 * 4 : 0;
  for (int it = blockIdx.x; it < nA + nB + nC + nD; it += gridDim.x) {
    f32x16 acc[4][2];
    zero_acc(acc);
    OPQ_LANE
    if (it < nA) {
      int i = it; const int et = i & 1; i >>= 1; const int dir = i & 1; i >>= 1; const int hd = i & 3; i >>= 2; const int c = i & 7; const int ls = ls0 + (i >> 3);
      const int tl0 = ls * 4096 + c * 512;
      const u16* KT = dir ? p.KTb : p.KTf;
      gemm256(acc, p.VTr + (long)(hd * 512 + et * 256) * RROWS + tl0, RROWS, KT + (long)(hd * 256) * RROWS + tl0, RROWS, 512, smem);
      u16* dst = p.KV + ((long)((ls * 8 + c) * 4 + hd) * 2 + dir) * 131072;
#pragma unroll
      for (int tm = 0; tm < 4; ++tm) {
        SB0;
#pragma unroll
        for (int tn = 0; tn < 2; ++tn)
#pragma unroll
          for (int r = 0; r < 16; ++r)
            dst[(unsigned)(et * 256 + CROW(tm, r)) * 256 + CCOL(tn)] = f2bf(acc[tm][tn][r]);
      }
    } else if (it < nA + nB + nC) {
      int tl0, hd, ib, jb;
      if (it < nA + nB) {
        int i = it - nA; jb = (i & 1) * 256; i >>= 1; ib = (i & 1) * 256; i >>= 1; hd = i & 3; i >>= 2; const int c = i & 7; const int ls = ls0 + (i >> 3);
        tl0 = ls * 4096 + c * 512;
      } else {
        tl0 = 0; hd = 0; ib = 0; jb = 0;
      }
      if (it < nA + nB) {
        gemm256(acc, p.Qr + (long)(tl0 + ib) * 1024 + hd * 256, 1024, p.Kr + (long)(tl0 + jb) * 1024 + hd * 256, 1024, 256, smem);
        const float lf = lg2sig(p.dec_f[hd]), lb = lg2sig(p.dec_b[hd]);
#pragma unroll
        for (int tm = 0; tm < 4; ++tm) {
          SB0;
#pragma unroll
          for (int tn = 0; tn < 2; ++tn)
#pragma unroll
            for (int r = 0; r < 16; ++r) {
              const int pi = ib + CROW(tm, r), pj = jb + CCOL(tn);
              const int df = pi - pj;
              const float De = ex2(df > 0 ? (float)df * lf : (float)(-df) * lb); const float D = df == 0 ? 2.f : De;
              p.ATTb[(unsigned)(tl0 + pi) * 2048 + hd * 512 + pj] = f2bf(acc[tm][tn][r] * D);
            }
        }
      } else {
        int i = it - nA - nB; const int et = i & 1; i >>= 1; const int dir = i & 1; i >>= 1; const int hd2 = i & 3; i >>= 2; const int b = i;
        const int tl1 = b * 256;
        const u16* KT = dir ? p.KTb : p.KTf;
        gemm256(acc, KT + (long)(hd2 * 256) * RROWS + tl1, RROWS, p.VTr + (long)(hd2 * 512 + et * 256) * RROWS + tl1, RROWS, 256, smem);
        float* dst = p.out + (dir ? O_RB : O_RF) + (long)(b * 4 + hd2) * 131072;
#pragma unroll
        for (int tm = 0; tm < 4; ++tm) {
          SB0;
#pragma unroll
          for (int tn = 0; tn < 2; ++tn)
#pragma unroll
            for (int r = 0; r < 16; ++r)
              dst[(unsigned)(CROW(tm, r)) * 512 + et * 256 + CCOL(tn)] = acc[tm][tn][r];
        }
      }
    } else {
      int i = it - nA - nB - nC; const int hd = i & 3; i >>= 2; const int b = i;
      const int tl0 = b * 256;
      gemm256(acc, p.Qr + (long)tl0 * 1024 + hd * 256, 1024, p.Kr + (long)tl0 * 1024 + hd * 256, 1024, 256, smem);
      const float lf = lg2sig(p.dec_f[hd]), lb = lg2sig(p.dec_b[hd]);
#pragma unroll
      for (int tm = 0; tm < 4; ++tm) {
        SB0;
#pragma unroll
        for (int tn = 0; tn < 2; ++tn)
#pragma unroll
          for (int r = 0; r < 16; ++r) {
            const int pi = CROW(tm, r), pj = CCOL(tn);
            const int df = pi - pj;
            const float De = ex2(df > 0 ? (float)df * lf : (float)(-df) * lb); const float D = df == 0 ? 2.f : De;
            p.ATTb[(unsigned)(tl0 + pi) * 2048 + hd * 512 + pj] = f2bf(acc[tm][tn][r] * D);
          }
      }
    }
  }
}

DI void scan_phase(const Params& p, int round) {
  const int nsamp = round == 0 ? 2 : 3, ls0 = round == 0 ? 1 : 0;
  int gz_ = threadIdx.x; asm volatile("" : "+v"(gz_));
  const int gid = blockIdx.x * NTH + gz_, gsz = gridDim.x * NTH;
  for (int i = gid; i < RROWS * 4; i += gsz) p.rowss[i] = 0.f;
  const int total = nsamp * 4 * 2 * 65536;
  for (int i = gid; i < total; i += gsz) {
    const int idx2 = i & 65535; int j = i >> 16;
    const int dir = j & 1; j >>= 1; const int hd = j & 3; j >>= 2; const int ls = ls0 + j;
    const int e = idx2 >> 7, d = (idx2 & 127) * 2;
    const int sb = round * 3 + ls - 1;
    const float* st = (dir ? p.st_b : p.st_f) + ((size_t)(sb * 4 + hd) * 256 + d) * 512 + e;
    float S0 = st[0], S1 = st[512];
    const float lg = lg2sig(dir ? p.dec_b[hd] : p.dec_f[hd]);
    const float gL = ex2(512.f * lg);
    unsigned* base = (unsigned*)(p.KV + ((size_t)((ls * 8) * 4 + hd) * 2 + dir) * 131072) + idx2;
    unsigned kv[8];
#pragma unroll
    for (int c = 0; c < 8; ++c) kv[c] = base[(size_t)c * (4 * 2 * 131072 / 2)];
    if (dir == 0) {
#pragma unroll
      for (int c = 0; c < 8; ++c) {
        const float k0 = bf2f((u16)(kv[c] & 0xffff)), k1 = bf2f((u16)(kv[c] >> 16));
        kv[c] = pack2(S0, S1);
        S0 = gL * S0 + k0; S1 = gL * S1 + k1;
      }
    } else {
#pragma unroll
      for (int c = 7; c >= 0; --c) {
        const float k0 = bf2f((u16)(kv[c] & 0xffff)), k1 = bf2f((u16)(kv[c] >> 16));
        kv[c] = pack2(S0, S1);
        S0 = gL * S0 + k0; S1 = gL * S1 + k1;
      }
    }
#pragma unroll
    for (int c = 0; c < 8; ++c) base[(size_t)c * (4 * 2 * 131072 / 2)] = kv[c];
  }
}

DI void r3_phase(const Params& p, int round, char* smem) {
  TLW
  const int nsamp = round == 0 ? 2 : 3, ls0 = round == 0 ? 1 : 0;
  const int nA = nsamp * 8 * 4 * 4;
  const int nB = round == 0 ? 16 * 4 * 2 : 0;
  for (int it = blockIdx.x; it < nA + nB; it += gridDim.x) {
    f32x16 acc[4][2];
    zero_acc(acc);
    OPQ_LANE
    int tl0, hd, ib, et;
    if (it < nA) {
      int i = it; et = i & 1; i >>= 1; ib = (i & 1) * 256; i >>= 1; hd = i & 3; i >>= 2; const int c = i & 7; const int ls = ls0 + (i >> 3);
      tl0 = ls * 4096 + c * 512;
      const float lf = lg2sig(p.dec_f[hd]), lb = lg2sig(p.dec_b[hd]);
      const u16* Aq = p.Qr + (long)(tl0 + ib) * 1024 + hd * 256;
      const u16* Sf = p.KV + ((long)((ls * 8 + c) * 4 + hd) * 2 + 0) * 131072 + (long)et * 256 * 256;
      const u16* Sb = p.KV + ((long)((ls * 8 + c) * 4 + hd) * 2 + 1) * 131072 + (long)et * 256 * 256;
      gemm256(acc, Aq, 1024, Sf, 256, 256, smem);
      const float pbase = (float)(ib + wr * 128 + 4 * (lane >> 5));
      const float e1s = lf + lb, e1b = pbase * e1s + lf - 512.f * lb, e2b = (512.f - pbase) * lb;
#pragma unroll
      for (int tm = 0; tm < 4; ++tm) {
        SB0;
#pragma unroll
        for (int r = 0; r < 16; ++r) {
          const float sc = ex2(e1b + (float)(tm * 32 + (r & 3) + 8 * (r >> 2)) * e1s);
          acc[tm][0][r] *= sc; acc[tm][1][r] *= sc;
        }
      }
      gemm256(acc, Aq, 1024, Sb, 256, 256, smem);
#pragma unroll
      for (int tm = 0; tm < 4; ++tm) {
        SB0;
#pragma unroll
        for (int r = 0; r < 16; ++r) {
          const float sc = ex2(e2b - (float)(tm * 32 + (r & 3) + 8 * (r >> 2)) * lb);
          acc[tm][0][r] *= sc; acc[tm][1][r] *= sc;
        }
      }
      gemm256(acc, p.ATTb + (long)(tl0 + ib) * 2048 + hd * 512, 2048, p.VTr + (long)(hd * 512 + et * 256) * RROWS + tl0, RROWS, 512, smem);
    } else {
      int i = it - nA; et = i & 1; i >>= 1; hd = i & 3; i >>= 2; const int b = i;
      ib = 0;
      tl0 = b * 256;
      gemm256(acc, p.ATTb + (long)tl0 * 2048 + hd * 512, 2048, p.VTr + (long)(hd * 512 + et * 256) * RROWS + tl0, RROWS, 256, smem);
    }
#pragma unroll
    for (int tm = 0; tm < 4; ++tm) {
      SB0;
      float ssv = 0.f;
#pragma unroll
      for (int r = 0; r < 16; ++r) {
        const int tl = tl0 + ib + CROW(tm, r);
        const float a0 = acc[tm][0][r], a1 = acc[tm][1][r];
        const float sd = red32_dpp(a0 * a0 + a1 * a1);
        { const float lo_ = rl31(sd), hi_ = rl63(sd); ssv = (lane == r) ? lo_ : ssv; ssv = (lane == 16 + r) ? hi_ : ssv; }
        u16* o = p.Ob + (unsigned)tl * 2048 + hd * 512 + et * 256;
        o[CCOL(0)] = f2bf(a0); o[CCOL(1)] = f2bf(a1);
      }
      if (lane < 32) {
        const int rr = lane & 15, hh = lane >> 4;
        const int tl = tl0 + ib + wr * 128 + tm * 32 + (rr & 3) + 8 * (rr >> 2) + 4 * hh;
        atomicAdd(p.rowss + (unsigned)tl * 4 + hd, ssv);
      }
    }
  }
}

DI void gate_phase(const Params& p) {
  int gz_ = threadIdx.x; asm volatile("" : "+v"(gz_));
  const int gid = blockIdx.x * NTH + gz_, gsz = gridDim.x * NTH;
  for (int i0 = gid; i0 < RROWS * 512; i0 += 4 * gsz) {
    uint2 ov[4], gv[4]; float4 gn[4]; float rs[4];
#pragma unroll
    for (int u = 0; u < 4; ++u) {
      const int i = i0 + u * gsz;
      if (i < RROWS * 512) {
        const int tl = i >> 9, c4 = (i & 511) * 4;
        ov[u] = *(const uint2*)(p.Ob + (size_t)tl * 2048 + c4);
        gv[u] = *(const uint2*)(p.SG + (size_t)tl * 2048 + c4);
        gn[u] = *(const float4*)(p.gn + c4);
        rs[u] = p.rowss[(size_t)tl * 4 + (c4 >> 9)];
      }
    }
#pragma unroll
    for (int u = 0; u < 4; ++u) {
      const int i = i0 + u * gsz;
      if (i < RROWS * 512) {
        const int tl = i >> 9, c4 = (i & 511) * 4;
        const float rinv = rsqrtf(rs[u] * (1.f / 512.f) + EPSF);
        const float o0 = bf2f((u16)(ov[u].x & 0xffff)) * rinv * gn[u].x * bf2f((u16)(gv[u].x & 0xffff));
        const float o1 = bf2f((u16)(ov[u].x >> 16)) * rinv * gn[u].y * bf2f((u16)(gv[u].x >> 16));
        const float o2 = bf2f((u16)(ov[u].y & 0xffff)) * rinv * gn[u].z * bf2f((u16)(gv[u].y & 0xffff));
        const float o3 = bf2f((u16)(ov[u].y >> 16)) * rinv * gn[u].w * bf2f((u16)(gv[u].y >> 16));
        uint2 pk; pk.x = pack2(o0, o1); pk.y = pack2(o2, o3);
        *(uint2*)(p.Ob + (size_t)tl * 2048 + c4) = pk;
      }
    }
  }
}

DI void grid_bar(unsigned* ctr, unsigned epoch) {
  asm volatile("s_waitcnt vmcnt(0)" ::: "memory");
  __syncthreads();
  if (threadIdx.x == 0) {
    __builtin_amdgcn_fence(__ATOMIC_RELEASE, "agent");
    asm volatile("s_waitcnt vmcnt(0)" ::: "memory");
    const unsigned g = blockIdx.x & 7u;
    const unsigned gsize = (gridDim.x + 7u - g) >> 3;
    const unsigned old = __hip_atomic_fetch_add(ctr + 32 + g * 32, 1u, __ATOMIC_RELAXED, __HIP_MEMORY_SCOPE_AGENT);
    if (old + 1u == gsize * epoch) __hip_atomic_fetch_add(ctr, 1u, __ATOMIC_RELAXED, __HIP_MEMORY_SCOPE_AGENT);
    const unsigned ngroups = gridDim.x < 8u ? gridDim.x : 8u;
    while (__hip_atomic_load(ctr, __ATOMIC_RELAXED, __HIP_MEMORY_SCOPE_AGENT) < ngroups * epoch) __builtin_amdgcn_s_sleep(2);
    __builtin_amdgcn_fence(__ATOMIC_ACQUIRE, "agent");
    asm volatile("s_waitcnt vmcnt(0)" ::: "memory");
  }
  __syncthreads();
}

#if !MULTI_LAUNCH
__global__ void __launch_bounds__(512, 2) mega_kernel(Params p) {
  __shared__ __attribute__((aligned(1024))) char smem[131072];
  cg::grid_group grid = cg::this_grid();
  unsigned bar_n = 0;
#define GBAR { bar_n += 1; grid_bar(p.bar, bar_n); }
  if (blockIdx.x == 0 && threadIdx.x < 512) __hip_atomic_store(p.bar + threadIdx.x, 0u, __ATOMIC_RELAXED, __HIP_MEMORY_SCOPE_AGENT);
  prep_phase(p, smem); grid.sync();
  norm_phase(p, 0, 0, true); GBAR
  in0_phase(p, smem); GBAR
  attn_phase(p, smem); GBAR
  gemm_simple_phase(p, 0, 0, p.ATT, 1024, p.wt_out0, 1024, 4, 0, 144, 2, 576, 1, smem); GBAR
  norm_phase(p, 0, 1, false); GBAR
  gemm_simple_phase(p, 1, 0, p.H, 1024, p.wt_w1[0], 1024, 16, 0, 144, 0, 2304, 1, smem); GBAR
  gemm_simple_phase(p, 2, 0, p.FF, 4096, p.wt_w2[0], 4096, 4, 0, 144, 5, 512, 4, smem); GBAR
  norm_phase(p, 1, 0, false, true); GBAR
  in1_out1_phase(p, 0, -1, smem); GBAR
#define ROUND_PHASES(round)                          \
    kvatt_phase(p, round, smem); GBAR                \
    scan_phase(p, round); GBAR                       \
    r3_phase(p, round, smem); GBAR                   \
    gate_phase(p); GBAR                              \
    in1_out1_phase(p, (round) + 1, round, smem); GBAR
  ROUND_PHASES(0)
  ROUND_PHASES(1)
  ROUND_PHASES(2)
  norm_phase(p, 1, 1, false); GBAR
  gemm_simple_phase(p, 1, 1, p.H, 1024, p.wt_w1[1], 1024, 16, 0, 144, 0, 2304, 1, smem); GBAR
  gemm_simple_phase(p, 2, 1, p.FF, 4096, p.wt_w2[1], 4096, 4, 0, 144, 5, 512, 4, smem); GBAR
  norm_phase(p, 0, 2, false, true);
}
#endif

extern "C" void kernel_launch(void* const* d_in, const int* in_sizes, int n_in, void* d_out, int out_size, void* d_ws, size_t ws_size,
                              hipStream_t stream) {
  Params p{};
  const float* const* in = (const float* const*)d_in;
  p.x_prompt = in[0]; p.x_sample = in[1]; p.c = in[2]; p.ck_a = in[3]; p.cv_a = in[4]; p.ck_s = in[5]; p.cv_s = in[6];
  p.st_f = in[7]; p.st_b = in[8]; p.c_ctx = in[9];
  p.ada_w[0] = in[10]; p.ada_b[0] = in[11]; p.norm_mix[0] = in[12]; p.norm_mlp[0] = in[13];
  p.w_in0 = in[14]; p.q_norm = in[15]; p.k_norm = in[16]; p.sink = in[17]; p.w_out0 = in[18]; p.w1[0] = in[19]; p.w2[0] = in[20];
  p.ada_w[1] = in[21]; p.ada_b[1] = in[22]; p.norm_mix[1] = in[23]; p.norm_mlp[1] = in[24];
  p.w_in1 = in[25]; p.dec_f = in[26]; p.dec_b = in[27]; p.gn = in[28]; p.w_out1 = in[29]; p.w1[1] = in[30]; p.w2[1] = in[31];
  p.final_norm = in[32];
  p.out = (float*)d_out;
  char* w = (char*)d_ws;
  size_t off = 0;
  auto take = [&](size_t bytes) { char* r = w + off; off += (bytes + 255) & ~(size_t)255; return r; };
  p.wt_in0 = (u16*)take(1536UL * 1024 * 2);
  p.wt_out0 = (u16*)take(1024UL * 1024 * 2);
  p.wt_in1 = (u16*)take(6144UL * 1024 * 2);
  p.wt_out1 = (u16*)take(1024UL * 2048 * 2);
  for (int l = 0; l < 2; ++l) { p.wt_w1[l] = (u16*)take(4096UL * 1024 * 2); p.wt_w2[l] = (u16*)take(4096UL * 1024 * 2); }
  p.mod = (float*)take(2UL * 9 * 6144 * 4);
  p.tab0 = (float2*)take(1024UL * 8);
  p.tab1 = (float2*)take(4096UL * 8);
  p.rowss = (float*)take((size_t)RROWS * 4 * 4);
  p.bar = (unsigned*)take(2048);
  p.H = (u16*)take((size_t)NT * 1024 * 2);
  const size_t ubase = off;
  p.Q0 = (u16*)take((size_t)NT * 1024 * 2);
  p.ATT = (u16*)take((size_t)NT * 1024 * 2);
  for (int k = 0; k < 2; ++k) {
    p.KS[k] = (u16*)take(8UL * 2 * 4608 * 64 * 2);
    p.VTS[k] = (u16*)take(8UL * 2 * 4608 * 64 * 2);
    p.KP[k] = (u16*)take(16UL * 2 * 256 * 64 * 2);
    p.VTP[k] = (u16*)take(16UL * 2 * 256 * 64 * 2);
  }
  size_t end0 = off;
  off = ubase;
  p.FF = (u16*)take((size_t)NT * 4096 * 2);
  p.PT = (float*)take(3UL * 4096 * 1024 * 4);
  size_t end1 = off;
  off = ubase;
  p.Qr = (u16*)take((size_t)RROWS * 1024 * 2);
  p.Kr = (u16*)take((size_t)RROWS * 1024 * 2);
  p.KTf = (u16*)take((size_t)RROWS * 1024 * 2);
  p.KTb = (u16*)take((size_t)RROWS * 1024 * 2);
  p.VTr = (u16*)take((size_t)RROWS * 2048 * 2);
  p.SG = (u16*)take((size_t)RROWS * 2048 * 2);
  p.KV = (u16*)take(24UL * 4 * 2 * 131072 * 2);
  p.ATTb = (u16*)take((size_t)RROWS * 2048 * 2);
  p.Ob = (u16*)take((size_t)RROWS * 2048 * 2);
  size_t end2 = off;
  size_t need = end0 > end1 ? end0 : end1; if (end2 > need) need = end2;
  if (need > ws_size) { fprintf(stderr, "workspace too small: need %zu have %zu\n", need, ws_size); return; }

#if 0
#else
  static int grid_blocks = 0;
  if (!grid_blocks) {
    int dev = 0, cus = 0, per_cu = 0;
    hipGetDevice(&dev);
    hipDeviceGetAttribute(&cus, hipDeviceAttributeMultiprocessorCount, dev);
    hipOccupancyMaxActiveBlocksPerMultiprocessor(&per_cu, mega_kernel, 512, 0);
    if (per_cu > 1) per_cu = 1;
    grid_blocks = cus * per_cu;
  }
  void* args[] = {&p};
  hipError_t e = hipLaunchCooperativeKernel((void*)mega_kernel, dim3(grid_blocks), dim3(512), args, 0, stream);
  if (e != hipSuccess) fprintf(stderr, "cooperative launch failed: %s (grid %d)\n", hipGetErrorString(e), grid_blocks);
#endif
}
```
